# Optimizing an MI355X kernel written in HIP

```python
import jax, jax.numpy as jnp
from jax import lax
import numpy as np

D_MODEL = 2048
BATCH = 4
SEQ = 2048
DEPTH = 4

GRID_W = 64
CTX_LEN = 256
MIX_W = D_MODEL
SC_W = MIX_W // 2
SC_WIDTH = 3
CF_W = MIX_W - SC_W
CF_KERNEL = 31
EVEN_IN = 3 * SC_W + 2 * CF_W
NA_HEAD_DIM = 128
NA_HEADS = (MIX_W // 2) // NA_HEAD_DIM
NA_W = NA_HEADS * NA_HEAD_DIM
NA_ROWS = 8
NA_COLS = 16
POOL_WINDOWS = (2, 4, 8, 16)
N_POOL = len(POOL_WINDOWS)
POOL_W = MIX_W - NA_W
POOL_GC = POOL_W // N_POOL
ODD_IN = 3 * NA_W + POOL_W
MOE_GROUPS = 4
EXPERTS_PER_GROUP = 8
N_EXPERTS = MOE_GROUPS * EXPERTS_PER_GROUP
MOE_TOP_K = 2
EXPERT_FF = D_MODEL // 8
RMS_EPS = 1e-6
LN_EPS = 1e-5
NEG_INF = -1e30

kernel_name = 'hybrid_flow_conv_natten_pool_hmoe'


def rmsnorm(x, g):
    x32 = x.astype(jnp.float32)
    y = x32 * lax.rsqrt(jnp.mean(x32 * x32, axis=-1, keepdims=True) + RMS_EPS)
    return (y * g.astype(jnp.float32)).astype(x.dtype)


def layernorm(x, g, b):
    x32 = x.astype(jnp.float32)
    mu = jnp.mean(x32, axis=-1, keepdims=True)
    var = jnp.mean(jnp.square(x32 - mu), axis=-1, keepdims=True)
    y = (x32 - mu) * lax.rsqrt(var + LN_EPS)
    return (y * g.astype(jnp.float32) + b.astype(jnp.float32)).astype(x.dtype)


def depthwise_conv(x, w):
    k = w.shape[0]
    return lax.conv_general_dilated(
        x, w[:, None, :].astype(x.dtype), window_strides=(1,),
        padding=[(k // 2, k // 2)], dimension_numbers=('NWC', 'WIO', 'NWC'),
        feature_group_count=x.shape[-1])


def conv_mixers(h, w_in, conv_a, dw_w, dw_b, ln_g, ln_b, w_out):
    u = h @ w_in
    b_gate, c_gate, xa, glu_a, glu_b = jnp.split(
        u, [SC_W, 2 * SC_W, 3 * SC_W, 3 * SC_W + CF_W], axis=-1)
    y_a = b_gate * depthwise_conv(c_gate * xa, conv_a)
    z = glu_a * jax.nn.sigmoid(glu_b)
    z = depthwise_conv(z, dw_w) + dw_b.astype(z.dtype)
    z = jax.nn.silu(layernorm(z, ln_g, ln_b))
    return jnp.concatenate([y_a, z], axis=-1) @ w_out


def multiscale_pool(p, pool_w, pool_scale):
    bsz, length, _ = p.shape
    pg = p.reshape(bsz, length, N_POOL, POOL_GC)
    pg32 = pg.astype(jnp.float32)
    cs = jnp.concatenate([jnp.zeros((bsz, 1, N_POOL, POOL_GC), jnp.float32),
                          jnp.cumsum(pg32, axis=1)], axis=1)
    win = jnp.array(POOL_WINDOWS, dtype=jnp.int32)[None, :]
    t = jnp.arange(length, dtype=jnp.int32)[:, None]
    lo = jnp.maximum(t - win // 2, 0)
    hi = jnp.minimum(t - win // 2 + win - 1, length - 1)
    gidx = jnp.arange(N_POOL)[None, :]
    s = cs[:, hi + 1, gidx] - cs[:, lo, gidx]
    cnt = (hi - lo + 1).astype(jnp.float32)[None, :, :, None]
    mix = (s / cnt - pg32).astype(p.dtype)
    y = jnp.einsum('blgc,gce->blge', mix, pool_w) * pool_scale.reshape(N_POOL, POOL_GC)
    return y.reshape(bsz, length, POOL_W)


def neighbourhood_attention(q, k, v, kc, vc, rpb):
    bsz, length, heads, dh = q.shape
    rows = length // GRID_W
    kr = min(NA_ROWS, rows)
    scale = dh ** -0.5
    qg = q.reshape(bsz, rows, GRID_W, heads, dh)
    kg = k.reshape(bsz, rows, GRID_W, heads, dh)
    vg = v.reshape(bsz, rows, GRID_W, heads, dh)
    r = jnp.arange(rows)
    r_start = jnp.clip(r - kr // 2, 0, rows - kr)
    ridx = r_start[:, None] + jnp.arange(kr)[None, :]
    kw = kg[:, ridx]
    vw = vg[:, ridx]
    s_win = jnp.einsum('brqhd,brjwhd->brhqjw', qg, kw).astype(jnp.float32) * scale
    cols = jnp.arange(GRID_W)
    c_start = jnp.clip(cols - NA_COLS // 2, 0, GRID_W - NA_COLS)
    col_mask = (cols[None, :] >= c_start[:, None]) & (cols[None, :] < c_start[:, None] + NA_COLS)
    dr = ridx - r[:, None] + (NA_ROWS - 1)
    dc = jnp.clip(cols[None, :] - cols[:, None], -(NA_COLS - 1), NA_COLS - 1) + (NA_COLS - 1)
    bias = rpb[:, dr[:, None, :, None], dc[None, :, None, :]]
    s_win = s_win + jnp.transpose(bias, (1, 0, 2, 3, 4)).astype(jnp.float32)[None]
    s_win = jnp.where(col_mask[:, None, :], s_win, NEG_INF)
    s_ctx = jnp.einsum('brqhd,bchd->brhqc', qg, kc).astype(jnp.float32) * scale
    n_win = kr * GRID_W
    s = jnp.concatenate([s_win.reshape(bsz, rows, heads, GRID_W, n_win), s_ctx], axis=-1)
    p = jax.nn.softmax(s, axis=-1).astype(v.dtype)
    p_win = p[..., :n_win].reshape(bsz, rows, heads, GRID_W, kr, GRID_W)
    p_ctx = p[..., n_win:]
    o = (jnp.einsum('brhqjw,brjwhd->brqhd', p_win, vw)
         + jnp.einsum('brhqc,bchd->brqhd', p_ctx, vc))
    return o.reshape(bsz, length, heads * dh)


def context_attention(qc, kc, vc):
    bsz, n, heads, dh = qc.shape
    s = jnp.einsum('bqhd,bkhd->bhqk', qc, kc).astype(jnp.float32) * (dh ** -0.5)
    p = jax.nn.softmax(s, axis=-1).astype(vc.dtype)
    return jnp.einsum('bhqk,bkhd->bqhd', p, vc).reshape(bsz, n, heads * dh)


def attn_pool_mixers(h_lat, h_ctx, w_in, rpb, pool_w, pool_scale, w_out, ctx_out):
    bsz, length, _ = h_lat.shape
    u = h_lat @ w_in
    q, k, v, p = jnp.split(u, [NA_W, 2 * NA_W, 3 * NA_W], axis=-1)
    heads4 = lambda a: a.reshape(a.shape[0], a.shape[1], NA_HEADS, NA_HEAD_DIM)
    if ctx_out:
        qc, kc, vc, pc = jnp.split(h_ctx @ w_in, [NA_W, 2 * NA_W, 3 * NA_W], axis=-1)
    else:
        kc, vc = jnp.split(h_ctx @ w_in[:, NA_W:3 * NA_W], 2, axis=-1)
    kc, vc = heads4(kc), heads4(vc)
    y_na = neighbourhood_attention(heads4(q), heads4(k), heads4(v), kc, vc, rpb)
    y_lat = jnp.concatenate([y_na, multiscale_pool(p, pool_w, pool_scale)], axis=-1) @ w_out
    if not ctx_out:
        return y_lat, None
    y_cna = context_attention(heads4(qc), kc, vc)
    y_ctx = jnp.concatenate([y_cna, multiscale_pool(pc, pool_w, pool_scale)], axis=-1) @ w_out
    return y_lat, y_ctx


def hier_moe(h, rg_w, rg_b, re_w, re_b, w1, w3, w2):
    shape = h.shape
    t = h.reshape(-1, shape[-1])
    n = t.shape[0]
    g_prob = jax.nn.softmax((t @ rg_w).astype(jnp.float32) + rg_b.astype(jnp.float32), axis=-1)
    g_p, g_idx = lax.top_k(g_prob, 1)
    e_logits = ((t @ re_w).astype(jnp.float32) + re_b.astype(jnp.float32)).reshape(
        n, MOE_GROUPS, EXPERTS_PER_GROUP)
    e_logits = jnp.take_along_axis(e_logits, g_idx[:, :, None], axis=1)[:, 0]
    e_p, e_idx = lax.top_k(jax.nn.softmax(e_logits, axis=-1), MOE_TOP_K)
    gate = g_p * e_p / jnp.sum(e_p, axis=-1, keepdims=True)
    expert = g_idx * EXPERTS_PER_GROUP + e_idx
    combine = jnp.sum(jax.nn.one_hot(expert, N_EXPERTS, dtype=jnp.float32) * gate[..., None], axis=1)
    a = jnp.einsum('nd,edf->nef', t, w1)
    b = jnp.einsum('nd,edf->nef', t, w3)
    hid = jax.nn.silu(a) * b * combine[:, :, None].astype(t.dtype)
    return jnp.einsum('nef,efd->nd', hid, w2).reshape(shape)


def setup_inputs(seed: int = 0) -> dict:
    key = jax.random.key(seed)
    ks = iter(jax.random.split(key, 32))

    def nrm(shape, std):
        return jax.random.normal(next(ks), shape, jnp.float32) * std

    d = D_MODEL
    ne = (DEPTH + 1) // 2
    no = DEPTH // 2
    return {
        'x': nrm((BATCH, SEQ, d), 1.0),
        'c': nrm((BATCH, d), 1.0),
        'ctx': nrm((BATCH, CTX_LEN, d), 1.0),
        'c_ctx': nrm((d,), 1.0),
        'ada_w': nrm((DEPTH, d, 6 * d), 0.5 * d ** -0.5),
        'ada_b': nrm((DEPTH, 6 * d), 0.02),
        'norm1_g': 1.0 + nrm((DEPTH, d), 0.02),
        'norm2_g': 1.0 + nrm((DEPTH, d), 0.02),
        'ev_w_in': nrm((ne, d, EVEN_IN), d ** -0.5),
        'ev_conv_a': nrm((ne, SC_WIDTH, SC_W), SC_WIDTH ** -0.5),
        'ev_dw_w': nrm((ne, CF_KERNEL, CF_W), CF_KERNEL ** -0.5),
        'ev_dw_b': nrm((ne, CF_W), 0.02),
        'ev_ln_g': 1.0 + nrm((ne, CF_W), 0.02),
        'ev_ln_b': nrm((ne, CF_W), 0.02),
        'ev_w_out': nrm((ne, MIX_W, d), MIX_W ** -0.5),
        'od_w_in': nrm((no, d, ODD_IN), d ** -0.5),
        'od_rpb': nrm((no, NA_HEADS, 2 * NA_ROWS - 1, 2 * NA_COLS - 1), 0.1),
        'od_pool_w': nrm((no, N_POOL, POOL_GC, POOL_GC), POOL_GC ** -0.5),
        'od_pool_scale': 1.0 + nrm((no, POOL_W), 0.02),
        'od_w_out': nrm((no, MIX_W, d), MIX_W ** -0.5),
        'moe_rg_w': nrm((DEPTH, d, MOE_GROUPS), d ** -0.5),
        'moe_rg_b': nrm((DEPTH, MOE_GROUPS), 0.01),
        'moe_re_w': nrm((DEPTH, d, N_EXPERTS), d ** -0.5),
        'moe_re_b': nrm((DEPTH, N_EXPERTS), 0.01),
        'moe_w1': nrm((DEPTH, N_EXPERTS, d, EXPERT_FF), d ** -0.5),
        'moe_w3': nrm((DEPTH, N_EXPERTS, d, EXPERT_FF), d ** -0.5),
        'moe_w2': nrm((DEPTH, N_EXPERTS, EXPERT_FF, d), EXPERT_FF ** -0.5),
        'final_g': 1.0 + nrm((d,), 0.02),
    }


def reference(x, c, ctx, c_ctx, ada_w, ada_b, norm1_g, norm2_g,
              ev_w_in, ev_conv_a, ev_dw_w, ev_dw_b, ev_ln_g, ev_ln_b, ev_w_out,
              od_w_in, od_rpb, od_pool_w, od_pool_scale, od_w_out,
              moe_rg_w, moe_rg_b, moe_re_w, moe_re_b, moe_w1, moe_w3, moe_w2,
              final_g):
    d = x.shape[-1]
    bsz = x.shape[0]
    x_lat, x_ctx = x, ctx
    for i in range(DEPTH):
        last = i == DEPTH - 1
        j = i // 2
        odd = i % 2 == 1
        need_ctx_in = (not last) or odd
        mod = (jax.nn.silu(c) @ ada_w[i] + ada_b[i]).reshape(bsz, 6, 1, d)
        mod_c = (jax.nn.silu(c_ctx) @ ada_w[i] + ada_b[i]).reshape(6, d)
        h_lat = rmsnorm(x_lat, norm1_g[i]) * (1 + mod[:, 1]) + mod[:, 0]
        h_ctx = rmsnorm(x_ctx, norm1_g[i]) * (1 + mod_c[1]) + mod_c[0] if need_ctx_in else None
        if odd:
            y_lat, y_ctx = attn_pool_mixers(h_lat, h_ctx, od_w_in[j], od_rpb[j], od_pool_w[j],
                                            od_pool_scale[j], od_w_out[j], not last)
        else:
            ev = (ev_w_in[j], ev_conv_a[j], ev_dw_w[j], ev_dw_b[j], ev_ln_g[j], ev_ln_b[j], ev_w_out[j])
            y_lat = conv_mixers(h_lat, *ev)
            y_ctx = None if last else conv_mixers(h_ctx, *ev)
        x_lat = x_lat + mod[:, 2] * y_lat
        if not last:
            x_ctx = x_ctx + mod_c[2] * y_ctx
        moe = (moe_rg_w[i], moe_rg_b[i], moe_re_w[i], moe_re_b[i], moe_w1[i], moe_w3[i], moe_w2[i])
        h2_lat = rmsnorm(x_lat, norm2_g[i]) * (1 + mod[:, 4]) + mod[:, 3]
        if last:
            x_lat = x_lat + mod[:, 5] * hier_moe(h2_lat, *moe)
        else:
            h2_ctx = rmsnorm(x_ctx, norm2_g[i]) * (1 + mod_c[4]) + mod_c[3]
            n_ctx = x_ctx.shape[1]
            f = hier_moe(jnp.concatenate([h2_ctx, h2_lat], axis=1), *moe)
            x_ctx = x_ctx + mod_c[5] * f[:, :n_ctx]
            x_lat = x_lat + mod[:, 5] * f[:, n_ctx:]
    return rmsnorm(x_lat, final_g)
```

```cpp
#include <hip/hip_runtime.h>
#include <cstdio>
#include <cstdint>

#ifndef TRUNC
#define TRUNC 0
#endif
#ifndef DUMP_SEL
#define DUMP_SEL 2
#endif
#ifndef PHM
#define PHM 0xffffffffu
#endif
#define ON(k) (((PHM) >> (k)) & 1u)
#ifndef MK_N_LAUNCHES
#define MK_N_LAUNCHES 1
#endif

#define LAS __attribute__((address_space(3)))
typedef unsigned short bf16_t;
typedef short bf16x8 __attribute__((ext_vector_type(8)));
typedef float f32x4 __attribute__((ext_vector_type(4)));
typedef float f32x2 __attribute__((ext_vector_type(2)));
typedef unsigned u32x4 __attribute__((ext_vector_type(4)));
typedef unsigned u32x2 __attribute__((ext_vector_type(2)));

constexpr int D = 2048, NB = 4, SEQ = 2048, CTXL = 256, DEPTH = 4;
constexpr int NLAT = NB * SEQ, NCTX = NB * CTXL, NTOK = NLAT + NCTX;
constexpr int EVEN_IN = 5120, ODD_IN = 4096, MODW = 6 * D;
constexpr int NEXP = 32, FF = 256;
constexpr int SLOT_CAP = NTOK;
constexpr int HID_ROWS = 26624;

constexpr size_t al256(size_t x) { return (x + 255) & ~(size_t)255; }
constexpr size_t WS_CTL = 0, CTL_BYTES = 65536;
constexpr int CW_CNT = 8192;
constexpr size_t WS_MOD = WS_CTL + CTL_BYTES;
constexpr size_t WS_WRT = al256(WS_MOD + (size_t)DEPTH * 5 * MODW * 4);
constexpr size_t WS_TOKG = al256(WS_WRT + (size_t)DEPTH * 36 * D * 4);
constexpr size_t WS_SLOT = al256(WS_TOKG + (size_t)NTOK * 2 * 4);
constexpr size_t WS_X = al256(WS_SLOT + (size_t)NEXP * SLOT_CAP * 4);
constexpr size_t WS_H = al256(WS_X + (size_t)NTOK * D * 4);
constexpr size_t WS_U = al256(WS_H + (size_t)NTOK * D * 2);
constexpr size_t WS_VT = al256(WS_U + (size_t)NTOK * EVEN_IN * 2);
constexpr size_t WS_AMIX = al256(WS_VT + (size_t)1024 * NTOK * 2);
constexpr size_t WS_MIX = al256(WS_AMIX + (size_t)NTOK * D * 2);
constexpr size_t WS_HID = al256(WS_MIX + (size_t)NTOK * 1024 * 2);
constexpr size_t WS_Y2 = al256(WS_HID + (size_t)HID_ROWS * FF * 2);
constexpr size_t WS_EVWIN = al256(WS_Y2 + (size_t)NTOK * 2 * D * 2);
constexpr size_t WS_EVWOUT = al256(WS_EVWIN + (size_t)2 * EVEN_IN * D * 2);
constexpr size_t WS_ODWIN = al256(WS_EVWOUT + (size_t)2 * D * D * 2);
constexpr size_t WS_ODWOUT = al256(WS_ODWIN + (size_t)2 * ODD_IN * D * 2);
constexpr size_t WS_POOLW = al256(WS_ODWOUT + (size_t)2 * D * D * 2);
constexpr size_t WS_W13 = al256(WS_POOLW + (size_t)2 * 1024 * 256 * 2);
constexpr size_t WS_W2 = al256(WS_W13 + (size_t)DEPTH * NEXP * 512 * D * 2);
constexpr size_t WS_END = al256(WS_W2 + (size_t)DEPTH * NEXP * D * FF * 2);

constexpr int LDS_BYTES = 147456;
constexpr int LDS_MISC = 147456 - 256;

#define XB_TMO      128
#define XB_XCNT(j)  (256  + 64 * (j))
#define XB_XSUB(j)  (1280 + 64 * (j))
#define XB_XGEN(j)  (2304 + 64 * (j))
#define XB_TOP      3328
#define XB_TOPGEN   3392
#define XCD_BAR_WORDS 3456
#define XB_SPIN_CAP (1u << 18)

__device__ __forceinline__ unsigned xb_ld(unsigned* p)              { return __hip_atomic_load(p, __ATOMIC_RELAXED, __HIP_MEMORY_SCOPE_AGENT); }
__device__ __forceinline__ unsigned xb_add(unsigned* p, unsigned v) { return __hip_atomic_fetch_add(p, v, __ATOMIC_RELAXED, __HIP_MEMORY_SCOPE_AGENT); }
__device__ __forceinline__ unsigned xb_xcc_id() { return (unsigned)__builtin_amdgcn_s_getreg((3 << 11) | 20) & 0xFu; }
#define XB_SPIN(cond, bar) do { unsigned _sp = 0; while (cond) { __builtin_amdgcn_s_sleep(1); \
    if ((++_sp & 255u) == 0u) { if (xb_ld(&(bar)[XB_TMO])) break; if (_sp > XB_SPIN_CAP) { atomicAdd(&(bar)[XB_TMO], 1u); break; } } } } while (0)

struct XcdBarrier { unsigned* bar; unsigned x; volatile LAS unsigned* st; };

__device__ __forceinline__ XcdBarrier xcd_barrier_post(unsigned* bar, volatile LAS unsigned* st) {
    XcdBarrier b; b.bar = bar; b.x = xb_xcc_id(); b.st = st;
    if (threadIdx.x == 0) (void)xb_add(&bar[XB_XCNT(b.x)], 1u);
    return b;
}
__device__ __forceinline__ void xcd_barrier_complete(unsigned* bar, unsigned x, unsigned& nloc, unsigned& nx) {
    const unsigned G = gridDim.x * gridDim.y * gridDim.z;
    unsigned sum, cnt, mine, sp = 0u;
    for (;;) {
        sum = 0u; cnt = 0u; mine = 0u;
#pragma unroll
        for (unsigned j = 0; j < 16; ++j) { const unsigned c = xb_ld(&bar[XB_XCNT(j)]); sum += c; cnt += (c > 0u) ? 1u : 0u; mine = (j == x) ? c : mine; }
        if (sum == G) break;
        __builtin_amdgcn_s_sleep(1);
        if ((++sp & 255u) == 0u) { if (xb_ld(&bar[XB_TMO])) break; if (sp > XB_SPIN_CAP) { atomicAdd(&bar[XB_TMO], 1u); break; } }
    }
    nloc = mine > 0u ? mine : 1u; nx = cnt > 0u ? cnt : 1u;
}
__device__ __forceinline__ void xcd_barrier(const XcdBarrier& b) {
    asm volatile("s_waitcnt vmcnt(0)" ::: "memory");
    __syncthreads();
    if (threadIdx.x == 0) {
        unsigned* bar = b.bar;
        __builtin_amdgcn_s_waitcnt(0);
        unsigned nloc = b.st[0], nx = b.st[1];
        if (nloc == 0u) { xcd_barrier_complete(bar, xb_xcc_id(), nloc, nx); b.st[0] = nloc; b.st[1] = nx; }
        const unsigned old = xb_add(&bar[XB_XSUB(b.x)], 1u);
        const unsigned gen = old / nloc;
        if (old + 1u == (gen + 1u) * nloc) {
            __builtin_amdgcn_fence(__ATOMIC_RELEASE, "agent");
            asm volatile("s_waitcnt vmcnt(0)" ::: "memory");
            const unsigned og = xb_add(&bar[XB_TOP], 1u);
            const unsigned tg = og / nx;
            if (og + 1u == (tg + 1u) * nx) xb_add(&bar[XB_TOPGEN], 1u);
            else XB_SPIN(xb_ld(&bar[XB_TOPGEN]) == tg, bar);
            __builtin_amdgcn_fence(__ATOMIC_ACQUIRE, "agent");
            xb_add(&bar[XB_XGEN(b.x)], 1u);
            asm volatile("s_waitcnt vmcnt(0)" ::: "memory");
        } else {
            XB_SPIN(xb_ld(&bar[XB_XGEN(b.x)]) == gen, bar);
            __builtin_amdgcn_fence(__ATOMIC_ACQUIRE, "agent");
            asm volatile("s_waitcnt vmcnt(0)" ::: "memory");
        }
    }
    __syncthreads();
}

typedef __bf16 bf16v2_t __attribute__((ext_vector_type(2)));
__device__ __forceinline__ unsigned cvt_pk_bf16(float lo, float hi) { const f32x2 v = {lo, hi}; const bf16v2_t r = __builtin_convertvector(v, bf16v2_t); return __builtin_bit_cast(unsigned, r); }
__device__ __forceinline__ float bf_lo(unsigned u) { return __uint_as_float(u << 16); }
__device__ __forceinline__ float bf_hi(unsigned u) { return __uint_as_float(u & 0xffff0000u); }
__device__ __forceinline__ float wave_sum(float v) {
#pragma unroll
    for (int o = 32; o; o >>= 1) v += __shfl_xor(v, o);
    return v;
}
__device__ __forceinline__ float sigmoidf_(float x) { return 1.0f / (1.0f + __expf(-x)); }
__device__ __forceinline__ float siluf_(float x) { return x / (1.0f + __expf(-x)); }

struct Args { const float* in[28]; float* out; unsigned char* ws; int ph_lo, ph_hi; };
#define CAS __attribute__((address_space(4)))
struct Frame {
    LAS unsigned char* lds; int tid, lane, wave; int G, bid;
    const CAS Args* ka;
    __device__ __forceinline__ const float* in(int i) const { return ka->in[i]; }
    __device__ __forceinline__ unsigned char* ws() const { return ka->ws; }
    __device__ __forceinline__ float* out() const { return ka->out; }
    __device__ __forceinline__ unsigned* ctl() const { return (unsigned*)(ws() + WS_CTL); }
    __device__ __forceinline__ float* MOD() const { return (float*)(ws() + WS_MOD); }
    __device__ __forceinline__ float* WRT() const { return (float*)(ws() + WS_WRT); }
    __device__ __forceinline__ float* TOKG() const { return (float*)(ws() + WS_TOKG); }
    __device__ __forceinline__ int* SLOT() const { return (int*)(ws() + WS_SLOT); }
    __device__ __forceinline__ float* X() const { return (float*)(ws() + WS_X); }
    __device__ __forceinline__ bf16_t* H() const { return (bf16_t*)(ws() + WS_H); }
    __device__ __forceinline__ bf16_t* U() const { return (bf16_t*)(ws() + WS_U); }
    __device__ __forceinline__ bf16_t* VT() const { return (bf16_t*)(ws() + WS_VT); }
    __device__ __forceinline__ bf16_t* AMIX() const { return (bf16_t*)(ws() + WS_AMIX); }
    __device__ __forceinline__ bf16_t* MIX() const { return (bf16_t*)(ws() + WS_MIX); }
    __device__ __forceinline__ bf16_t* HID() const { return (bf16_t*)(ws() + WS_HID); }
    __device__ __forceinline__ bf16_t* Y2() const { return (bf16_t*)(ws() + WS_Y2); }
    __device__ __forceinline__ bf16_t* EVWIN() const { return (bf16_t*)(ws() + WS_EVWIN); }
    __device__ __forceinline__ bf16_t* EVWOUT() const { return (bf16_t*)(ws() + WS_EVWOUT); }
    __device__ __forceinline__ bf16_t* ODWIN() const { return (bf16_t*)(ws() + WS_ODWIN); }
    __device__ __forceinline__ bf16_t* ODWOUT() const { return (bf16_t*)(ws() + WS_ODWOUT); }
    __device__ __forceinline__ bf16_t* POOLW() const { return (bf16_t*)(ws() + WS_POOLW); }
    __device__ __forceinline__ bf16_t* W13() const { return (bf16_t*)(ws() + WS_W13); }
    __device__ __forceinline__ bf16_t* W2() const { return (bf16_t*)(ws() + WS_W2); }
};

__device__ __forceinline__ Frame phase_frame(const Frame& F0) {
    Frame F = F0;
    int t = F0.tid; asm volatile("" : "+v"(t));
    F.tid = t; F.lane = t & 63; F.wave = __builtin_amdgcn_readfirstlane(t >> 6);
    unsigned long long k = (unsigned long long)F0.ka; asm volatile("" : "+s"(k)); F.ka = (const CAS Args*)k;
    int b = F0.bid; asm volatile("" : "+s"(b)); F.bid = b;
    return F;
}

__device__ __forceinline__ void p0_convert(const Frame& F) {
    LAS float* T = (LAS float*)F.lds;
    const int tid = F.tid;
#pragma unroll 1
    for (int j = 0; j < 8; ++j) {
        const float* src; bf16_t* dst; int nb, K, N, blk, bs, ro; size_t dstb;
        switch (j) {
            case 0: src = F.in(8);  dst = F.EVWIN();  nb = 2;   K = D;   N = EVEN_IN; blk = N;   bs = 0;   ro = 0;   dstb = (size_t)EVEN_IN * D; break;
            case 1: src = F.in(14); dst = F.EVWOUT(); nb = 2;   K = D;   N = D;       blk = N;   bs = 0;   ro = 0;   dstb = (size_t)D * D; break;
            case 2: src = F.in(15); dst = F.ODWIN();  nb = 2;   K = D;   N = ODD_IN;  blk = N;   bs = 0;   ro = 0;   dstb = (size_t)ODD_IN * D; break;
            case 3: src = F.in(19); dst = F.ODWOUT(); nb = 2;   K = D;   N = D;       blk = N;   bs = 0;   ro = 0;   dstb = (size_t)D * D; break;
            case 4: src = F.in(17); dst = F.POOLW();  nb = 8;   K = 256; N = 256;     blk = N;   bs = 0;   ro = 0;   dstb = (size_t)256 * 256; break;
            case 5: src = F.in(24); dst = F.W13();    nb = 128; K = D;   N = FF;      blk = 128; bs = 256; ro = 0;   dstb = (size_t)512 * D; break;
            case 6: src = F.in(25); dst = F.W13();    nb = 128; K = D;   N = FF;      blk = 128; bs = 256; ro = 128; dstb = (size_t)512 * D; break;
            default: src = F.in(26); dst = F.W2();    nb = 128; K = FF;  N = D;       blk = N;   bs = 0;   ro = 0;   dstb = (size_t)D * FF; break;
        }
        const int tk = K / 64, tn = N / 64, per = tk * tn, total = nb * per;
#pragma unroll 1
        for (int t = F.bid; t < total; t += F.G) {
            const int b = t / per, rem = t % per, k0 = (rem / tn) * 64, n0 = (rem % tn) * 64;
            const float* s = src + (size_t)b * K * N;
            bf16_t* d = dst + (size_t)b * dstb;
            { const int kr = tid >> 4, c4 = (tid & 15) * 4;
#pragma unroll
              for (int p = 0; p < 2; ++p) { const int k = kr + 32 * p; const f32x4 v = *(const f32x4*)(s + (size_t)(k0 + k) * N + n0 + c4);
                  T[k * 65 + c4 + 0] = v[0]; T[k * 65 + c4 + 1] = v[1]; T[k * 65 + c4 + 2] = v[2]; T[k * 65 + c4 + 3] = v[3]; } }
            __syncthreads();
            { const int n = tid >> 3, kc = (tid & 7) * 8;
              float v[8];
#pragma unroll
              for (int q = 0; q < 8; ++q) v[q] = T[(kc + q) * 65 + n];
              u32x4 w; w.x = cvt_pk_bf16(v[0], v[1]); w.y = cvt_pk_bf16(v[2], v[3]); w.z = cvt_pk_bf16(v[4], v[5]); w.w = cvt_pk_bf16(v[6], v[7]);
              const int ng = n0 + n, row = (ng / blk) * bs + (ng % blk) + ro;
              *(u32x4*)(d + (size_t)row * K + k0 + kc) = w; }
            __syncthreads();
        }
    }
    for (int i = F.bid * 512 + tid; i < DEPTH * 36 * D; i += F.G * 512) {
        const int l = i / (36 * D), c = (i / D) % 36, k = i % D;
        F.WRT()[i] = (c < 4) ? F.in(20)[((size_t)l * D + k) * 4 + c] : F.in(22)[((size_t)l * D + k) * 32 + (c - 4)];
    }
}

__device__ __forceinline__ void p0_mod(const Frame& F) {
    LAS float* sc = (LAS float*)F.lds;
    LAS float* red = sc + 5 * D;
    for (int i = F.tid; i < 5 * D; i += 512) { const float c = (i < 4 * D) ? F.in(1)[i] : F.in(3)[i - 4 * D]; sc[i] = siluf_(c); }
    __syncthreads();
    const int kq = F.lane >> 4, c4 = (F.lane & 15) * 4;
#pragma unroll 1
    for (int u = F.bid; u < DEPTH * 192; u += F.G) {
        const int l = u / 192, n0 = (u % 192) * 64;
        const float* W = F.in(4) + (size_t)l * D * MODW + n0 + c4;
        f32x4 acc[5];
#pragma unroll
        for (int s = 0; s < 5; ++s) acc[s] = (f32x4){0.f, 0.f, 0.f, 0.f};
#pragma unroll 4
        for (int it = 0; it < 64; ++it) {
            const int k = it * 32 + F.wave * 4 + kq;
            const f32x4 w = *(const f32x4*)(W + (size_t)k * MODW);
#pragma unroll
            for (int s = 0; s < 5; ++s) acc[s] += sc[s * D + k] * w;
        }
#pragma unroll
        for (int s = 0; s < 5; ++s)
#pragma unroll
            for (int i = 0; i < 4; ++i) { float v = acc[s][i]; v += __shfl_xor(v, 16); v += __shfl_xor(v, 32); acc[s][i] = v; }
        if (kq == 0) {
#pragma unroll
            for (int s = 0; s < 5; ++s)
#pragma unroll
                for (int i = 0; i < 4; ++i) red[(F.wave * 5 + s) * 64 + c4 + i] = acc[s][i];
        }
        __syncthreads();
        if (F.tid < 320) { const int s = F.tid >> 6, col = F.tid & 63; float v = F.in(5)[(size_t)l * MODW + n0 + col];
#pragma unroll
            for (int w = 0; w < 8; ++w) v += red[(w * 5 + s) * 64 + col];
            F.MOD()[((size_t)l * 5 + s) * MODW + n0 + col] = v; }
        __syncthreads();
    }
}

template <int MODE>
__device__ __forceinline__ void norm1_phase(const Frame& F, int l) {
    const int nrows = (MODE == 2) ? NLAT : NTOK;
    const float* g = (MODE == 2) ? F.in(27) : F.in(6) + (size_t)l * D;
#pragma unroll 1
    for (int r = F.bid * 8 + F.wave; r < nrows; r += F.G * 8) {
        const int s = r < NLAT ? r / SEQ : 4;
        f32x4 v[8];
        if (MODE == 0) {
            const float* src = r < NLAT ? F.in(0) + (size_t)r * D : F.in(2) + (size_t)(r - NLAT) * D;
#pragma unroll
            for (int j = 0; j < 8; ++j) v[j] = *(const f32x4*)(src + j * 256 + F.lane * 4);
        } else {
            const float* xr = F.X() + (size_t)r * D;
            const float* g5 = F.MOD() + ((size_t)(l - 1) * 5 + s) * MODW + 5 * D;
            const bf16_t* y = F.Y2() + (size_t)r * 2 * D;
#pragma unroll
            for (int j = 0; j < 8; ++j) {
                const int idx = j * 256 + F.lane * 4;
                const f32x4 x = *(const f32x4*)(xr + idx), gg = *(const f32x4*)(g5 + idx);
                const u32x2 a = *(const u32x2*)(y + idx), b = *(const u32x2*)(y + D + idx);
                f32x4 ys; ys[0] = bf_lo(a.x) + bf_lo(b.x); ys[1] = bf_hi(a.x) + bf_hi(b.x); ys[2] = bf_lo(a.y) + bf_lo(b.y); ys[3] = bf_hi(a.y) + bf_hi(b.y);
                v[j] = x + gg * ys;
            }
        }
        float ss = 0.f;
#pragma unroll
        for (int j = 0; j < 8; ++j) ss += v[j][0] * v[j][0] + v[j][1] * v[j][1] + v[j][2] * v[j][2] + v[j][3] * v[j][3];
        ss = wave_sum(ss);
        const float rstd = rsqrtf(ss * (1.0f / D) + 1e-6f);
        if (MODE == 2) {
            float* o = F.out() + (size_t)r * D;
#pragma unroll
            for (int j = 0; j < 8; ++j) { const int idx = j * 256 + F.lane * 4; *(f32x4*)(o + idx) = v[j] * rstd * *(const f32x4*)(g + idx); }
        } else {
            float* xr = F.X() + (size_t)r * D;
            const float* sh = F.MOD() + ((size_t)l * 5 + s) * MODW;
            const float* scl = sh + D;
            bf16_t* h = F.H() + (size_t)r * D;
#pragma unroll
            for (int j = 0; j < 8; ++j) {
                const int idx = j * 256 + F.lane * 4;
                *(f32x4*)(xr + idx) = v[j];
                const f32x4 hv = v[j] * rstd * *(const f32x4*)(g + idx) * (1.0f + *(const f32x4*)(scl + idx)) + *(const f32x4*)(sh + idx);
                u32x2 w; w.x = cvt_pk_bf16(hv[0], hv[1]); w.y = cvt_pk_bf16(hv[2], hv[3]);
                *(u32x2*)(h + idx) = w;
            }
        }
    }
}

__device__ __forceinline__ void norm2_router_phase(const Frame& F, int l) {
    const int nrows = (l == DEPTH - 1) ? NLAT : NTOK;
    LAS float* lg = (LAS float*)F.lds + F.wave * (4 * 36);
    const float* g2 = F.in(7) + (size_t)l * D;
    const float* wrt = F.WRT() + (size_t)l * 36 * D;
    unsigned* cnt = F.ctl() + CW_CNT + l * 32;
#pragma unroll 1
    for (int r0 = (F.bid * 8 + F.wave) * 4; r0 < nrows; r0 += F.G * 8 * 4) {
        const int s = r0 < NLAT ? r0 / SEQ : 4;
        const float* sh = F.MOD() + ((size_t)l * 5 + s) * MODW + 3 * D;
        const float* scl = sh + D;
        f32x4 hv[4][8];
#pragma unroll
        for (int rr = 0; rr < 4; ++rr) {
            const float* xr = F.X() + (size_t)(r0 + rr) * D;
            float ss = 0.f;
#pragma unroll
            for (int j = 0; j < 8; ++j) { hv[rr][j] = *(const f32x4*)(xr + j * 256 + F.lane * 4); ss += hv[rr][j][0] * hv[rr][j][0] + hv[rr][j][1] * hv[rr][j][1] + hv[rr][j][2] * hv[rr][j][2] + hv[rr][j][3] * hv[rr][j][3]; }
            ss = wave_sum(ss);
            const float rstd = rsqrtf(ss * (1.0f / D) + 1e-6f);
            bf16_t* h = F.H() + (size_t)(r0 + rr) * D;
#pragma unroll
            for (int j = 0; j < 8; ++j) {
                const int idx = j * 256 + F.lane * 4;
                hv[rr][j] = hv[rr][j] * rstd * *(const f32x4*)(g2 + idx) * (1.0f + *(const f32x4*)(scl + idx)) + *(const f32x4*)(sh + idx);
                u32x2 w; w.x = cvt_pk_bf16(hv[rr][j][0], hv[rr][j][1]); w.y = cvt_pk_bf16(hv[rr][j][2], hv[rr][j][3]);
                *(u32x2*)(h + idx) = w;
            }
        }
#pragma unroll 1
        for (int c = 0; c < 36; ++c) {
            const float* wc = wrt + (size_t)c * D;
            float d0 = 0.f, d1 = 0.f, d2 = 0.f, d3 = 0.f;
#pragma unroll
            for (int j = 0; j < 8; ++j) {
                const f32x4 w = *(const f32x4*)(wc + j * 256 + F.lane * 4);
                d0 += hv[0][j][0] * w[0] + hv[0][j][1] * w[1] + hv[0][j][2] * w[2] + hv[0][j][3] * w[3];
                d1 += hv[1][j][0] * w[0] + hv[1][j][1] * w[1] + hv[1][j][2] * w[2] + hv[1][j][3] * w[3];
                d2 += hv[2][j][0] * w[0] + hv[2][j][1] * w[1] + hv[2][j][2] * w[2] + hv[2][j][3] * w[3];
                d3 += hv[3][j][0] * w[0] + hv[3][j][1] * w[1] + hv[3][j][2] * w[2] + hv[3][j][3] * w[3];
            }
            d0 = wave_sum(d0); d1 = wave_sum(d1); d2 = wave_sum(d2); d3 = wave_sum(d3);
            if (F.lane == 0) { lg[0 * 36 + c] = d0; lg[1 * 36 + c] = d1; lg[2 * 36 + c] = d2; lg[3 * 36 + c] = d3; }
        }
        __builtin_amdgcn_fence(__ATOMIC_RELEASE, "workgroup");
        __builtin_amdgcn_wave_barrier();
        __builtin_amdgcn_fence(__ATOMIC_ACQUIRE, "workgroup");
        if (F.lane < 4) {
            const int rr = F.lane, r = r0 + rr;
            const LAS float* L = lg + rr * 36;
            float gl[4]; float gm = -3.0e38f; int gi = 0;
#pragma unroll
            for (int q = 0; q < 4; ++q) { gl[q] = L[q] + F.in(21)[l * 4 + q]; if (gl[q] > gm) { gm = gl[q]; gi = q; } }
            float gs = 0.f;
#pragma unroll
            for (int q = 0; q < 4; ++q) gs += __expf(gl[q] - gm);
            const float gp = 1.0f / gs;
            float el[8]; float m1 = -3.0e38f; int i1 = 0;
#pragma unroll
            for (int q = 0; q < 8; ++q) { el[q] = L[4 + gi * 8 + q] + F.in(23)[l * 32 + gi * 8 + q]; if (el[q] > m1) { m1 = el[q]; i1 = q; } }
            float m2 = -3.0e38f; int i2 = 0;
#pragma unroll
            for (int q = 0; q < 8; ++q) { if (q != i1 && el[q] > m2) { m2 = el[q]; i2 = q; } }
            const float e2 = __expf(m2 - m1);
            const float w1 = gp / (1.0f + e2), w2 = gp * e2 / (1.0f + e2);
            const int ex1 = gi * 8 + i1, ex2 = gi * 8 + i2;
            const unsigned p1 = atomicAdd(cnt + ex1, 1u), p2 = atomicAdd(cnt + ex2, 1u);
            F.SLOT()[(size_t)ex1 * SLOT_CAP + p1] = r * 2;
            F.SLOT()[(size_t)ex2 * SLOT_CAP + p2] = r * 2 + 1;
            F.TOKG()[r * 2] = w1; F.TOKG()[r * 2 + 1] = w2;
        }
        __builtin_amdgcn_wave_barrier();
    }
}

__device__ __forceinline__ void sgemm_core(const bf16_t* (&ap)[4], const bf16_t* bp0, const bf16_t* bp1, int K, f32x4 (&a)[4], f32x4 (&b)[4]) {
#pragma unroll
    for (int m = 0; m < 4; ++m) { a[m] = (f32x4){0.f, 0.f, 0.f, 0.f}; b[m] = (f32x4){0.f, 0.f, 0.f, 0.f}; }
#pragma unroll 2
    for (int k0 = 0; k0 < K; k0 += 32) {
        const bf16x8 b0 = *(const bf16x8*)(bp0 + k0), b1 = *(const bf16x8*)(bp1 + k0);
        bf16x8 af[4];
#pragma unroll
        for (int m = 0; m < 4; ++m) af[m] = *(const bf16x8*)(ap[m] + k0);
#pragma unroll
        for (int m = 0; m < 4; ++m) { a[m] = __builtin_amdgcn_mfma_f32_16x16x32_bf16(b0, af[m], a[m], 0, 0, 0); b[m] = __builtin_amdgcn_mfma_f32_16x16x32_bf16(b1, af[m], b[m], 0, 0, 0); }
    }
}

template <class Epi>
__device__ __forceinline__ void sgemm_phase(const Frame& F, const bf16_t* A, int lda, int a_pn_off, const bf16_t* Bt, int ldb, int M, int N, int K, const Epi& E) {
    const int fr = F.lane & 15, fq = F.lane >> 4;
    const int nM = M / 64, nN = N / 256, total = nM * nN;
#pragma unroll 1
    for (int u = F.bid; u < total; u += F.G) {
        const int pm = u / nN, pn = u % nN;
        const bf16_t* ap[4];
#pragma unroll
        for (int m = 0; m < 4; ++m) ap[m] = A + (size_t)(pm * 64 + m * 16 + fr) * lda + pn * a_pn_off + 8 * fq;
        const bf16_t* bp0 = Bt + (size_t)(pn * 256 + F.wave * 16 + fr) * ldb + 8 * fq;
        const bf16_t* bp1 = bp0 + (size_t)128 * ldb;
        f32x4 a[4], b[4];
        sgemm_core(ap, bp0, bp1, K, a, b);
#pragma unroll
        for (int m = 0; m < 4; ++m) E(pm * 64 + m * 16 + fr, pn * 256 + F.wave * 16 + 4 * fq, a[m], b[m]);
    }
}

__device__ __forceinline__ void st_bf16x4(bf16_t* p, f32x4 v) { u32x2 w; w.x = cvt_pk_bf16(v[0], v[1]); w.y = cvt_pk_bf16(v[2], v[3]); *(u32x2*)p = w; }

struct EpiU {
    bf16_t* U; int ldu; bf16_t* VT; int odd;
    __device__ __forceinline__ void operator()(int row, int col, f32x4 a, f32x4 b) const {
        st_bf16x4(U + (size_t)row * ldu + col, a); st_bf16x4(U + (size_t)row * ldu + col + 128, b);
        if (odd && col >= 2048 && col < 3072) {
#pragma unroll
            for (int i = 0; i < 4; ++i) {
                VT[(size_t)(col - 2048 + i) * NTOK + row] = (bf16_t)(cvt_pk_bf16(a[i], 0.f) & 0xffffu);
                VT[(size_t)(col - 2048 + 128 + i) * NTOK + row] = (bf16_t)(cvt_pk_bf16(b[i], 0.f) & 0xffffu);
            }
        }
    }
};
struct EpiPool {
    bf16_t* AMIX; const float* scale;
    __device__ __forceinline__ void operator()(int row, int col, f32x4 a, f32x4 b) const {
        st_bf16x4(AMIX + (size_t)row * D + 1024 + col, a * *(const f32x4*)(scale + col));
        st_bf16x4(AMIX + (size_t)row * D + 1024 + col + 128, b * *(const f32x4*)(scale + col + 128));
    }
};
struct EpiRes {
    float* X; const float* MODl;
    __device__ __forceinline__ void operator()(int row, int col, f32x4 a, f32x4 b) const {
        const int s = row < NLAT ? row / SEQ : 4;
        const float* g = MODl + (size_t)s * MODW;
        float* x = X + (size_t)row * D + col;
        *(f32x4*)x = *(const f32x4*)x + *(const f32x4*)(g + col) * a;
        *(f32x4*)(x + 128) = *(const f32x4*)(x + 128) + *(const f32x4*)(g + col + 128) * b;
    }
};

__device__ __forceinline__ void conv_phase(const Frame& F, int je) {
    LAS bf16_t* zt = (LAS bf16_t*)F.lds;
    LAS float* part = (LAS float*)(F.lds + 46 * 1024 * 2);
    LAS float* stat = part + 16 * 8 * 2;
    const int ch = 2 * F.tid;
    const float* cw = F.in(9) + (size_t)je * 3 * 1024;
    const float* dw = F.in(10) + (size_t)je * 31 * 1024;
    const f32x2 dwb = *(const f32x2*)(F.in(11) + (size_t)je * 1024 + ch);
    const f32x2 lng = *(const f32x2*)(F.in(12) + (size_t)je * 1024 + ch);
    const f32x2 lnb = *(const f32x2*)(F.in(13) + (size_t)je * 1024 + ch);
    const f32x2 ca0 = *(const f32x2*)(cw + ch), ca1 = *(const f32x2*)(cw + 1024 + ch), ca2 = *(const f32x2*)(cw + 2048 + ch);
    constexpr int UL = NLAT / 16, UC = NCTX / 16;
#pragma unroll 1
    for (int u = F.bid; u < UL + UC; u += F.G) {
        int srow0, L, t0;
        if (u < UL) { const int b = u / (SEQ / 16); srow0 = b * SEQ; L = SEQ; t0 = (u % (SEQ / 16)) * 16; }
        else { const int v = u - UL, b = v / (CTXL / 16); srow0 = NLAT + b * CTXL; L = CTXL; t0 = (v % (CTXL / 16)) * 16; }
        const bf16_t* Ub = F.U() + (size_t)srow0 * EVEN_IN;
#pragma unroll 2
        for (int rr = 0; rr < 46; ++rr) {
            const int t = t0 - 15 + rr; unsigned zz = 0u;
            if (t >= 0 && t < L) {
                const unsigned ga = *(const unsigned*)(Ub + (size_t)t * EVEN_IN + 3072 + ch), gb = *(const unsigned*)(Ub + (size_t)t * EVEN_IN + 4096 + ch);
                zz = cvt_pk_bf16(bf_lo(ga) * sigmoidf_(bf_lo(gb)), bf_hi(ga) * sigmoidf_(bf_hi(gb)));
            }
            *(LAS unsigned*)(zt + rr * 1024 + ch) = zz;
        }
        float z0[16], z1[16];
#pragma unroll
        for (int t = 0; t < 16; ++t) { z0[t] = dwb.x; z1[t] = dwb.y; }
#pragma unroll 1
        for (int jj = 0; jj < 31; ++jj) {
            const f32x2 w = *(const f32x2*)(dw + (size_t)jj * 1024 + ch);
            const LAS bf16_t* zp = zt + jj * 1024 + ch;
#pragma unroll
            for (int t = 0; t < 16; ++t) { const unsigned zz = *(const LAS unsigned*)(zp + t * 1024); z0[t] += w.x * bf_lo(zz); z1[t] += w.y * bf_hi(zz); }
        }
#pragma unroll
        for (int t = 0; t < 16; ++t) {
            float s1 = z0[t] + z1[t], s2 = z0[t] * z0[t] + z1[t] * z1[t];
            s1 = wave_sum(s1); s2 = wave_sum(s2);
            if (F.lane == 0) { part[(t * 8 + F.wave) * 2] = s1; part[(t * 8 + F.wave) * 2 + 1] = s2; }
        }
        __syncthreads();
        if (F.tid < 16) { float s1 = 0.f, s2 = 0.f;
#pragma unroll
            for (int w = 0; w < 8; ++w) { s1 += part[(F.tid * 8 + w) * 2]; s2 += part[(F.tid * 8 + w) * 2 + 1]; }
            const float mu = s1 * (1.0f / 1024.0f); float var = s2 * (1.0f / 1024.0f) - mu * mu; var = var < 0.f ? 0.f : var;
            stat[F.tid * 2] = mu; stat[F.tid * 2 + 1] = rsqrtf(var + 1e-5f); }
        __syncthreads();
        bf16_t* Ab = F.AMIX() + (size_t)(srow0 + t0) * D;
#pragma unroll
        for (int t = 0; t < 16; ++t) {
            const float mu = stat[t * 2], rs = stat[t * 2 + 1];
            const float y0 = (z0[t] - mu) * rs * lng.x + lnb.x, y1 = (z1[t] - mu) * rs * lng.y + lnb.y;
            *(unsigned*)(Ab + (size_t)t * D + 1024 + ch) = cvt_pk_bf16(siluf_(y0), siluf_(y1));
        }
        {
            float p0 = 0.f, p1 = 0.f, c0 = 0.f, c1 = 0.f;
            if (t0 - 1 >= 0) { const unsigned cg = *(const unsigned*)(Ub + (size_t)(t0 - 1) * EVEN_IN + 1024 + ch), xa = *(const unsigned*)(Ub + (size_t)(t0 - 1) * EVEN_IN + 2048 + ch); p0 = bf_lo(cg) * bf_lo(xa); p1 = bf_hi(cg) * bf_hi(xa); }
            { const unsigned cg = *(const unsigned*)(Ub + (size_t)t0 * EVEN_IN + 1024 + ch), xa = *(const unsigned*)(Ub + (size_t)t0 * EVEN_IN + 2048 + ch); c0 = bf_lo(cg) * bf_lo(xa); c1 = bf_hi(cg) * bf_hi(xa); }
#pragma unroll
            for (int t = 0; t < 16; ++t) {
                const int tn = t0 + t + 1; float n0 = 0.f, n1 = 0.f;
                if (tn < L) { const unsigned cg = *(const unsigned*)(Ub + (size_t)tn * EVEN_IN + 1024 + ch), xa = *(const unsigned*)(Ub + (size_t)tn * EVEN_IN + 2048 + ch); n0 = bf_lo(cg) * bf_lo(xa); n1 = bf_hi(cg) * bf_hi(xa); }
                const unsigned bg = *(const unsigned*)(Ub + (size_t)(t0 + t) * EVEN_IN + ch);
                const float y0 = bf_lo(bg) * (ca0.x * p0 + ca1.x * c0 + ca2.x * n0), y1 = bf_hi(bg) * (ca0.y * p1 + ca1.y * c1 + ca2.y * n1);
                *(unsigned*)(Ab + (size_t)t * D + ch) = cvt_pk_bf16(y0, y1);
                p0 = c0; p1 = c1; c0 = n0; c1 = n1;
            }
        }
        __syncthreads();
    }
}

__device__ __forceinline__ void attn_unit(const Frame& F, int jo, int qrow0, int kwrow0, int kcrow0, int h, int r, int r_start) {
    LAS bf16_t* Pl = (LAS bf16_t*)F.lds;
    LAS float* pm = (LAS float*)(F.lds + 64 * 776 * 2);
    LAS float* ps = pm + 64 * 8;
    constexpr int PLS = 776;
    const int w = F.wave, fr = F.lane & 15, fq = F.lane >> 4;
    const bool has_win = kwrow0 >= 0;
    const bf16_t* U = F.U();
    f32x4 acc[4][6];
#pragma unroll
    for (int m = 0; m < 4; ++m)
#pragma unroll
        for (int nt = 0; nt < 6; ++nt) acc[m][nt] = (f32x4){0.f, 0.f, 0.f, 0.f};
    {
        const bf16_t* qp = U + (size_t)(qrow0 + fr) * ODD_IN + h * 128 + 8 * fq;
        const bf16_t* kwp = U + (size_t)((has_win ? kwrow0 : kcrow0) + 64 * w + fr) * ODD_IN + 1024 + h * 128 + 8 * fq;
        const bf16_t* kcp = U + (size_t)(kcrow0 + 32 * w + fr) * ODD_IN + 1024 + h * 128 + 8 * fq;
#pragma unroll
        for (int kk = 0; kk < 4; ++kk) {
            bf16x8 qf[4];
#pragma unroll
            for (int m = 0; m < 4; ++m) qf[m] = *(const bf16x8*)(qp + (size_t)(16 * m) * ODD_IN + 32 * kk);
#pragma unroll
            for (int nt = 0; nt < 6; ++nt) {
                if (nt < 4 && !has_win) continue;
                const bf16x8 kf = nt < 4 ? *(const bf16x8*)(kwp + (size_t)(16 * nt) * ODD_IN + 32 * kk) : *(const bf16x8*)(kcp + (size_t)(16 * (nt - 4)) * ODD_IN + 32 * kk);
#pragma unroll
                for (int m = 0; m < 4; ++m) acc[m][nt] = __builtin_amdgcn_mfma_f32_16x16x32_bf16(kf, qf[m], acc[m][nt], 0, 0, 0);
            }
        }
    }
    const float scale = 0.08838834764831845f;
    const float* rpb = F.in(16) + ((size_t)(jo * 8 + h) * 15 + ((r_start + w) - r + 7)) * 31;
#pragma unroll
    for (int m = 0; m < 4; ++m) {
        const int qc = 16 * m + fr; int cs = qc - 8; cs = cs < 0 ? 0 : (cs > 48 ? 48 : cs);
        float mx = -3.0e38f;
#pragma unroll
        for (int nt = 0; nt < 6; ++nt)
#pragma unroll
            for (int i = 0; i < 4; ++i) {
                float sv;
                if (nt < 4) {
                    if (has_win) {
                        const int kcol = 16 * nt + 4 * fq + i;
                        int dc = kcol - qc; dc = dc < -15 ? -15 : (dc > 15 ? 15 : dc);
                        const int dd = kcol - cs;
                        const unsigned inval = (unsigned)((dd | (15 - dd)) >> 31);
                        const unsigned bits = __float_as_uint(acc[m][nt][i] * scale + rpb[dc + 15]);
                        sv = __uint_as_float((bits & ~inval) | (0xF149F2CAu & inval));
                    } else sv = -1.0e30f;
                } else sv = acc[m][nt][i] * scale;
                acc[m][nt][i] = sv; mx = fmaxf(mx, sv);
            }
        mx = fmaxf(mx, __shfl_xor(mx, 16)); mx = fmaxf(mx, __shfl_xor(mx, 32));
        if (fq == 0) pm[qc * 8 + w] = mx;
    }
    __syncthreads();
#pragma unroll
    for (int m = 0; m < 4; ++m) {
        const int qc = 16 * m + fr;
        const f32x4 ma = *(const LAS f32x4*)(pm + qc * 8), mb = *(const LAS f32x4*)(pm + qc * 8 + 4);
        const float M = fmaxf(fmaxf(fmaxf(ma[0], ma[1]), fmaxf(ma[2], ma[3])), fmaxf(fmaxf(mb[0], mb[1]), fmaxf(mb[2], mb[3])));
        float sum = 0.f;
#pragma unroll
        for (int nt = 0; nt < 6; ++nt) {
            if (nt < 4 && !has_win) continue;
            float p[4];
#pragma unroll
            for (int i = 0; i < 4; ++i) { p[i] = __expf(acc[m][nt][i] - M); sum += p[i]; }
            const int kidx = nt < 4 ? 64 * w + 16 * nt + 4 * fq : 512 + 32 * w + 16 * (nt - 4) + 4 * fq;
            u32x2 pk; pk.x = cvt_pk_bf16(p[0], p[1]); pk.y = cvt_pk_bf16(p[2], p[3]);
            *(LAS u32x2*)(Pl + qc * PLS + kidx) = pk;
        }
        sum += __shfl_xor(sum, 16); sum += __shfl_xor(sum, 32);
        if (fq == 0) ps[qc * 8 + w] = sum;
    }
    __syncthreads();
    f32x4 o[4];
#pragma unroll
    for (int m = 0; m < 4; ++m) o[m] = (f32x4){0.f, 0.f, 0.f, 0.f};
    const bf16_t* vt = F.VT() + (size_t)(h * 128 + 16 * w + fr) * NTOK + 8 * fq;
#pragma unroll 4
    for (int kk = 0; kk < 24; ++kk) {
        if (kk < 16 && !has_win) continue;
        const int tokbase = kk < 16 ? kwrow0 + 32 * kk : kcrow0 + 32 * (kk - 16);
        const bf16x8 vf = *(const bf16x8*)(vt + tokbase);
#pragma unroll
        for (int m = 0; m < 4; ++m) { const bf16x8 pf = *(const LAS bf16x8*)(Pl + (16 * m + fr) * PLS + 32 * kk + 8 * fq); o[m] = __builtin_amdgcn_mfma_f32_16x16x32_bf16(vf, pf, o[m], 0, 0, 0); }
    }
#pragma unroll
    for (int m = 0; m < 4; ++m) {
        const int qc = 16 * m + fr;
        const f32x4 sa = *(const LAS f32x4*)(ps + qc * 8), sb = *(const LAS f32x4*)(ps + qc * 8 + 4);
        const float inv = 1.0f / (((sa[0] + sa[1]) + (sa[2] + sa[3])) + ((sb[0] + sb[1]) + (sb[2] + sb[3])));
        st_bf16x4(F.AMIX() + (size_t)(qrow0 + qc) * D + h * 128 + 16 * w + 4 * fq, o[m] * inv);
    }
    __syncthreads();
}

__device__ __forceinline__ void attn_mix_phase(const Frame& F, int l) {
    const int jo = l >> 1;
    const bool last = (l == DEPTH - 1);
    const int nA = NB * 32 * 8, nC = last ? 0 : NB * 8 * 4, nMix = (last ? NLAT : NTOK) / 32;
#pragma unroll 1
    for (int u = F.bid; u < nA + nC + nMix; u += F.G) {
        if (u < nA) {
            const int h = u & 7, r = (u >> 3) & 31, b = u >> 8;
            int rs = r - 4; rs = rs < 0 ? 0 : (rs > 24 ? 24 : rs);
            attn_unit(F, jo, b * SEQ + r * 64, b * SEQ + rs * 64, NLAT + b * CTXL, h, r, rs);
        } else if (u < nA + nC) {
            const int v = u - nA, h = v & 7, qb = (v >> 3) & 3, b = v >> 5;
            attn_unit(F, jo, NLAT + b * CTXL + qb * 64, -1, NLAT + b * CTXL, h, 0, 0);
        } else {
            const int row0 = (u - nA - nC) * 32;
            int srow0, L;
            if (row0 < NLAT) { srow0 = (row0 / SEQ) * SEQ; L = SEQ; } else { srow0 = NLAT + ((row0 - NLAT) / CTXL) * CTXL; L = CTXL; }
            const int ch = 2 * F.tid, g = F.tid >> 7, win = 2 << g;
            const bf16_t* Ub = F.U() + (size_t)srow0 * ODD_IN + 3072 + ch;
#pragma unroll 1
            for (int tt = 0; tt < 32; ++tt) {
                const int t = row0 - srow0 + tt;
                int lo = t - win / 2; const int hi0 = lo + win - 1; lo = lo < 0 ? 0 : lo; const int hi = hi0 > L - 1 ? L - 1 : hi0;
                float s0 = 0.f, s1 = 0.f;
                for (int q = lo; q <= hi; ++q) { const unsigned pv = *(const unsigned*)(Ub + (size_t)q * ODD_IN); s0 += bf_lo(pv); s1 += bf_hi(pv); }
                const unsigned pc = *(const unsigned*)(Ub + (size_t)t * ODD_IN);
                const float inv = 1.0f / (float)(hi - lo + 1);
                *(unsigned*)(F.MIX() + (size_t)(row0 + tt) * 1024 + ch) = cvt_pk_bf16(s0 * inv - bf_lo(pc), s1 * inv - bf_hi(pc));
            }
        }
    }
}

__device__ __forceinline__ void moe_tiles(const Frame& F, int l, LAS int* ts) {
    if (F.tid == 0) { int acc = 0;
        for (int e = 0; e < NEXP; ++e) { const int c = (int)__hip_atomic_load(F.ctl() + CW_CNT + l * 32 + e, __ATOMIC_RELAXED, __HIP_MEMORY_SCOPE_AGENT); ts[e] = acc; ts[33 + e] = c; acc += (c + 255) >> 8; }
        ts[32] = acc; }
    __syncthreads();
}
__device__ __forceinline__ int moe_find(const LAS int* ts, int ti) { int e = 0;
#pragma unroll 1
    for (int q = 1; q < NEXP; ++q) e = (ts[q] <= ti) ? q : e;
    return e; }

__device__ __forceinline__ void moe_up_phase(const Frame& F, int l) {
    LAS int* ts = (LAS int*)(F.lds + 1024);
    moe_tiles(F, l, ts);
    const int T = ts[32], fr = F.lane & 15, fq = F.lane >> 4;
#pragma unroll 1
    for (int u = F.bid; u < T * 8; u += F.G) {
        const int ti = u >> 3, q = (u >> 1) & 3, pn = u & 1;
        const int e = moe_find(ts, ti), j = ti - ts[e], cnt = ts[33 + e];
        const int* sl = F.SLOT() + (size_t)e * SLOT_CAP;
        const bf16_t* ap[4]; int sv[4];
#pragma unroll
        for (int m = 0; m < 4; ++m) { const int li = j * 256 + q * 64 + m * 16 + fr; sv[m] = li < cnt ? sl[li] : -1; const int tok = sv[m] < 0 ? 0 : (sv[m] >> 1); ap[m] = F.H() + (size_t)tok * D + 8 * fq; }
        const bf16_t* Bt = F.W13() + ((size_t)l * NEXP + e) * 512 * D;
        const bf16_t* bp0 = Bt + (size_t)(pn * 256 + F.wave * 16 + fr) * D + 8 * fq;
        const bf16_t* bp1 = bp0 + (size_t)128 * D;
        f32x4 a[4], b[4];
        sgemm_core(ap, bp0, bp1, D, a, b);
#pragma unroll
        for (int m = 0; m < 4; ++m) {
            const float gate = sv[m] < 0 ? 0.f : F.TOKG()[sv[m]];
            f32x4 hv;
#pragma unroll
            for (int i = 0; i < 4; ++i) hv[i] = sv[m] < 0 ? 0.f : siluf_(a[m][i]) * b[m][i] * gate;
            st_bf16x4(F.HID() + (size_t)(ti * 256 + q * 64 + m * 16 + fr) * FF + pn * 128 + F.wave * 16 + 4 * fq, hv);
        }
    }
}
__device__ __forceinline__ void moe_down_phase(const Frame& F, int l) {
    LAS int* ts = (LAS int*)(F.lds + 1024);
    moe_tiles(F, l, ts);
    const int T = ts[32], fr = F.lane & 15, fq = F.lane >> 4;
#pragma unroll 1
    for (int u = F.bid; u < T * 32; u += F.G) {
        const int ti = u >> 5, q = (u >> 3) & 3, pn = u & 7;
        const int e = moe_find(ts, ti), j = ti - ts[e], cnt = ts[33 + e];
        const int* sl = F.SLOT() + (size_t)e * SLOT_CAP;
        const bf16_t* ap[4]; int sv[4];
#pragma unroll
        for (int m = 0; m < 4; ++m) { const int li = j * 256 + q * 64 + m * 16 + fr; sv[m] = li < cnt ? sl[li] : -1; ap[m] = F.HID() + (size_t)(ti * 256 + q * 64 + m * 16 + fr) * FF + 8 * fq; }
        const bf16_t* Bt = F.W2() + ((size_t)l * NEXP + e) * D * FF;
        const bf16_t* bp0 = Bt + (size_t)(pn * 256 + F.wave * 16 + fr) * FF + 8 * fq;
        const bf16_t* bp1 = bp0 + (size_t)128 * FF;
        f32x4 a[4], b[4];
        sgemm_core(ap, bp0, bp1, FF, a, b);
#pragma unroll
        for (int m = 0; m < 4; ++m) if (sv[m] >= 0) {
            bf16_t* y = F.Y2() + (size_t)sv[m] * D + pn * 256 + F.wave * 16 + 4 * fq;
            st_bf16x4(y, a[m]); st_bf16x4(y + 128, b[m]);
        }
    }
}

__global__ void __launch_bounds__(512, 2) hybrid_fwd(Args args) {
    extern __shared__ __attribute__((aligned(16))) unsigned char lds_raw[];
    Frame F;
    F.lds = (LAS unsigned char*)lds_raw;
    F.tid = threadIdx.x; F.lane = F.tid & 63; F.wave = __builtin_amdgcn_readfirstlane(F.tid >> 6);
    F.G = gridDim.x; F.bid = blockIdx.x;
    F.ka = (const CAS Args*)__builtin_amdgcn_kernarg_segment_ptr();

    volatile LAS unsigned* misc = (volatile LAS unsigned*)(F.lds + LDS_MISC);
    if (F.tid < 64) misc[F.tid] = 0u;
    __syncthreads();
    XcdBarrier bar; bar.bar = F.ctl(); bar.x = 0; bar.st = misc;
#if MK_N_LAUNCHES == 1
    bar = xcd_barrier_post(F.ctl(), misc);
#endif
    const int lo = F.ka->ph_lo, hi = F.ka->ph_hi;
    int ph = 0;
#if MK_N_LAUNCHES == 1
#define PHASE_BEGIN() ({ const bool run_ = (lo <= ph && ph < hi); if (run_ && ph > lo) xcd_barrier(bar); ++ph; run_; })
#else
#define PHASE_BEGIN() ({ const bool run_ = (lo <= ph && ph < hi); ++ph; run_; })
#endif

    if (PHASE_BEGIN()) { if (ON(0)) { const Frame P = phase_frame(F); p0_convert(P); p0_mod(P); } }
#pragma unroll 1
    for (int l = 0; l < DEPTH; ++l) {
        const bool odd = l & 1, last = (l == DEPTH - 1);
        const int jh = l >> 1;
        if (PHASE_BEGIN()) { if (ON(1)) { const Frame P = phase_frame(F); if (l == 0) norm1_phase<0>(P, l); else norm1_phase<1>(P, l); } }
        if (PHASE_BEGIN()) {
            const Frame P = phase_frame(F);
            const int N = odd ? ODD_IN : EVEN_IN;
            const bf16_t* Bt = odd ? P.ODWIN() + (size_t)jh * ODD_IN * D : P.EVWIN() + (size_t)jh * EVEN_IN * D;
            EpiU E{P.U(), N, P.VT(), odd ? 1 : 0};
            if (ON(2)) sgemm_phase(P, P.H(), D, 0, Bt, D, NTOK, N, D, E);
        }
        if (!odd) { if (PHASE_BEGIN()) { if (ON(3)) { const Frame P = phase_frame(F); conv_phase(P, jh); } } }
        else {
            if (PHASE_BEGIN()) { if (ON(4)) { const Frame P = phase_frame(F); attn_mix_phase(P, l); } }
            if (PHASE_BEGIN()) if (ON(5)) { const Frame P = phase_frame(F); EpiPool E{P.AMIX(), P.in(18) + (size_t)jh * 1024}; sgemm_phase(P, P.MIX(), 1024, 256, P.POOLW() + (size_t)jh * 1024 * 256, 256, last ? NLAT : NTOK, 1024, 256, E); }
        }
        if (PHASE_BEGIN()) {
            const Frame P = phase_frame(F);
            const bf16_t* Bt = odd ? P.ODWOUT() + (size_t)jh * D * D : P.EVWOUT() + (size_t)jh * D * D;
            EpiRes E{P.X(), P.MOD() + (size_t)l * 5 * MODW + 2 * D};
            if (ON(6)) sgemm_phase(P, P.AMIX(), D, 0, Bt, D, last ? NLAT : NTOK, D, D, E);
        }
        if (PHASE_BEGIN()) { if (ON(7)) { const Frame P = phase_frame(F); norm2_router_phase(P, l); } }
        if (PHASE_BEGIN()) { if (ON(8)) { const Frame P = phase_frame(F); moe_up_phase(P, l); } }
        if (PHASE_BEGIN()) { if (ON(9)) { const Frame P = phase_frame(F); moe_down_phase(P, l); } }
    }
    if (PHASE_BEGIN()) { if (ON(10)) { const Frame P = phase_frame(F); norm1_phase<2>(P, DEPTH); } }
#if TRUNC
    if (lo == 99) { const Frame P = phase_frame(F);
        for (size_t i = (size_t)P.bid * 512 + P.tid; i < (size_t)NLAT * D / 4; i += (size_t)P.G * 512) {
#if DUMP_SEL == 0
            ((f32x4*)P.out())[i] = ((const f32x4*)P.X())[i];
#elif DUMP_SEL == 1
            const u32x2 a = ((const u32x2*)P.AMIX())[i]; f32x4 v; v[0] = bf_lo(a.x); v[1] = bf_hi(a.x); v[2] = bf_lo(a.y); v[3] = bf_hi(a.y); ((f32x4*)P.out())[i] = v;
#elif DUMP_SEL == 2
            f32x4 v = {0.f, 0.f, 0.f, 0.f}; if (i < (size_t)1024 * NTOK / 4) { const u32x2 a = ((const u32x2*)P.VT())[i]; v[0] = bf_lo(a.x); v[1] = bf_hi(a.x); v[2] = bf_lo(a.y); v[3] = bf_hi(a.y); } ((f32x4*)P.out())[i] = v;
#else
            f32x4 v = {0.f, 0.f, 0.f, 0.f}; if (i < (size_t)1024 * NTOK / 4) { const u32x2 a = ((const u32x2*)P.MIX())[i]; v[0] = bf_lo(a.x); v[1] = bf_hi(a.x); v[2] = bf_lo(a.y); v[3] = bf_hi(a.y); } ((f32x4*)P.out())[i] = v;
#endif
        } }
#endif
}
constexpr int N_PHASES = 1 + (7 + 8 + 7 + 8) + 1;

extern "C" void kernel_launch(void* const* d_in, const int* in_sizes, int n_in, void* d_out, int out_size, void* d_ws, size_t ws_size, hipStream_t stream) {
    static int grid = 0;
    if (grid == 0) {
        if (n_in != 28 || in_sizes[0] != NLAT * D || out_size != NLAT * D || ws_size < WS_END) {
            fprintf(stderr, "kernel_launch: unexpected shapes (n_in %d, in0 %d, out %d, ws %zu < %zu); nothing launched\n", n_in, n_in > 0 ? in_sizes[0] : -1, out_size, ws_size, (size_t)WS_END); grid = -1; return; }
        int dev = 0, cus = 0, per_cu = 0;
        if (hipGetDevice(&dev) != hipSuccess || hipDeviceGetAttribute(&cus, hipDeviceAttributeMultiprocessorCount, dev) != hipSuccess) { grid = -1; return; }
        if (hipFuncSetAttribute((const void*)hybrid_fwd, hipFuncAttributeMaxDynamicSharedMemorySize, LDS_BYTES) != hipSuccess) { fprintf(stderr, "kernel_launch: hipFuncSetAttribute failed\n"); grid = -1; return; }
        if (hipOccupancyMaxActiveBlocksPerMultiprocessor(&per_cu, (const void*)hybrid_fwd, 512, LDS_BYTES) != hipSuccess || per_cu < 1)
            fprintf(stderr, "kernel_launch: occupancy query reports %d blocks per CU\n", per_cu);
        (void)hipGetLastError();
        grid = cus;
    }
    if (grid < 0) return;
    if (hipMemsetAsync((char*)d_ws + WS_CTL, 0, CTL_BYTES, stream) != hipSuccess) { fprintf(stderr, "kernel_launch: memset failed\n"); return; }
    Args a{};
    for (int i = 0; i < 28; ++i) a.in[i] = (const float*)d_in[i];
    a.out = (float*)d_out; a.ws = (unsigned char*)d_ws;
#if MK_N_LAUNCHES == 1
    a.ph_lo = 0; a.ph_hi = N_PHASES;
    hipLaunchKernelGGL(hybrid_fwd, dim3(grid), dim3(512), LDS_BYTES, stream, a);
#else
#if TRUNC
    for (int p = 0; p < TRUNC; ++p) { a.ph_lo = p; a.ph_hi = p + 1; hipLaunchKernelGGL(hybrid_fwd, dim3(grid), dim3(512), LDS_BYTES, stream, a); }
    a.ph_lo = 99; a.ph_hi = 100; hipLaunchKernelGGL(hybrid_fwd, dim3(grid), dim3(512), LDS_BYTES, stream, a);
#else
    for (int p = 0; p < N_PHASES; ++p) { a.ph_lo = p; a.ph_hi = p + 1; hipLaunchKernelGGL(hybrid_fwd, dim3(grid), dim3(512), LDS_BYTES, stream, a); }
#endif
#endif
    const hipError_t le = hipPeekAtLastError();
    if (le != hipSuccess) fprintf(stderr, "kernel_launch: launch failed: %s\n", hipGetErrorName(le));
}
```

```cpp
#include <hip/hip_runtime.h>
#include <cstdio>
#include <cstdint>

#ifndef TRUNC
#define TRUNC 0
#endif
#ifndef DUMP_SEL
#define DUMP_SEL 2
#endif
#ifndef PHM
#define PHM 0xffffffffu
#endif
#define ON(k) (((PHM) >> (k)) & 1u)
#ifndef MK_N_LAUNCHES
#define MK_N_LAUNCHES 1
#endif

#define LAS __attribute__((address_space(3)))
typedef unsigned short bf16_t;
typedef short bf16x8 __attribute__((ext_vector_type(8)));
typedef float f32x4 __attribute__((ext_vector_type(4)));
typedef float f32x2 __attribute__((ext_vector_type(2)));
typedef unsigned u32x4 __attribute__((ext_vector_type(4)));
typedef unsigned u32x2 __attribute__((ext_vector_type(2)));

constexpr int D = 2048, NB = 4, SEQ = 2048, CTXL = 256, DEPTH = 4;
constexpr int NLAT = NB * SEQ, NCTX = NB * CTXL, NTOK = NLAT + NCTX;
constexpr int EVEN_IN = 5120, ODD_IN = 4096, MODW = 6 * D;
constexpr int NEXP = 32, FF = 256;
constexpr int SLOT_CAP = NTOK;
constexpr int HID_ROWS = 26624;

constexpr size_t al256(size_t x) { return (x + 255) & ~(size_t)255; }
constexpr size_t WS_CTL = 0, CTL_BYTES = 65536;
constexpr int CW_CNT = 8192;
constexpr size_t WS_MOD = WS_CTL + CTL_BYTES;
constexpr size_t WS_WRT = al256(WS_MOD + (size_t)DEPTH * 5 * MODW * 4);
constexpr size_t WS_TOKG = al256(WS_WRT + (size_t)DEPTH * 36 * D * 4);
constexpr size_t WS_SLOT = al256(WS_TOKG + (size_t)NTOK * 2 * 4);
constexpr size_t WS_SLOTG = al256(WS_SLOT + (size_t)NEXP * SLOT_CAP * 4);
constexpr size_t WS_X = al256(WS_SLOTG + (size_t)NEXP * SLOT_CAP * 4);
constexpr size_t WS_H = al256(WS_X + (size_t)NTOK * D * 4);
constexpr size_t WS_U = al256(WS_H + (size_t)NTOK * D * 2);
constexpr size_t WS_VT = al256(WS_U + (size_t)NTOK * EVEN_IN * 2);
constexpr size_t WS_AMIX = al256(WS_VT + (size_t)1024 * NTOK * 2);
constexpr size_t WS_MIX = al256(WS_AMIX + (size_t)NTOK * D * 2);
constexpr size_t WS_HID = al256(WS_MIX + (size_t)NTOK * 1024 * 2);
constexpr size_t WS_Y2 = al256(WS_HID + (size_t)HID_ROWS * FF * 2);
constexpr size_t WS_EVWIN = al256(WS_Y2 + (size_t)NTOK * 2 * D * 2);
constexpr size_t WS_EVWOUT = al256(WS_EVWIN + (size_t)2 * EVEN_IN * D * 2);
constexpr size_t WS_ODWIN = al256(WS_EVWOUT + (size_t)2 * D * D * 2);
constexpr size_t WS_ODWOUT = al256(WS_ODWIN + (size_t)2 * ODD_IN * D * 2);
constexpr size_t WS_POOLW = al256(WS_ODWOUT + (size_t)2 * D * D * 2);
constexpr size_t WS_W13 = al256(WS_POOLW + (size_t)2 * 1024 * 256 * 2);
constexpr size_t WS_W2 = al256(WS_W13 + (size_t)DEPTH * NEXP * 512 * D * 2);
constexpr size_t WS_END = al256(WS_W2 + (size_t)DEPTH * NEXP * D * FF * 2);

constexpr int LDS_BYTES = 147456;
constexpr int LDS_MISC = 147456 - 256;

#define XB_TMO      128
#define XB_XCNT(j)  (256  + 64 * (j))
#define XB_XSUB(j)  (1280 + 64 * (j))
#define XB_XGEN(j)  (2304 + 64 * (j))
#define XB_TOP      3328
#define XB_TOPGEN   3392
#define XCD_BAR_WORDS 3456
#define XB_SPIN_CAP (1u << 18)

__device__ __forceinline__ unsigned xb_ld(unsigned* p)              { return __hip_atomic_load(p, __ATOMIC_RELAXED, __HIP_MEMORY_SCOPE_AGENT); }
__device__ __forceinline__ unsigned xb_add(unsigned* p, unsigned v) { return __hip_atomic_fetch_add(p, v, __ATOMIC_RELAXED, __HIP_MEMORY_SCOPE_AGENT); }
__device__ __forceinline__ unsigned xb_xcc_id() { return (unsigned)__builtin_amdgcn_s_getreg((3 << 11) | 20) & 0xFu; }
#define XB_SPIN(cond, bar) do { unsigned _sp = 0; while (cond) { __builtin_amdgcn_s_sleep(1); \
    if ((++_sp & 255u) == 0u) { if (xb_ld(&(bar)[XB_TMO])) break; if (_sp > XB_SPIN_CAP) { atomicAdd(&(bar)[XB_TMO], 1u); break; } } } } while (0)

struct XcdBarrier { unsigned* bar; unsigned x; volatile LAS unsigned* st; int wave; };
__device__ __forceinline__ bool xb_thread0(int wave) { int z = 0; asm volatile("" : "+s"(z)); return wave == 0 && __builtin_amdgcn_mbcnt_hi(~0u, __builtin_amdgcn_mbcnt_lo(~0u, (unsigned)z)) == 0u; }

__device__ __forceinline__ XcdBarrier xcd_barrier_post(unsigned* bar, volatile LAS unsigned* st) {
    XcdBarrier b; b.bar = bar; b.x = xb_xcc_id(); b.st = st;
    b.wave = __builtin_amdgcn_readfirstlane((int)(threadIdx.x >> 6));
    if (threadIdx.x == 0) (void)xb_add(&bar[XB_XCNT(b.x)], 1u);
    return b;
}
__device__ __forceinline__ void xcd_barrier_complete(unsigned* bar, unsigned x, unsigned& nloc, unsigned& nx) {
    const unsigned G = gridDim.x * gridDim.y * gridDim.z;
    unsigned sum, cnt, mine, sp = 0u;
    for (;;) {
        sum = 0u; cnt = 0u; mine = 0u;
#pragma unroll
        for (unsigned j = 0; j < 16; ++j) { const unsigned c = xb_ld(&bar[XB_XCNT(j)]); sum += c; cnt += (c > 0u) ? 1u : 0u; mine = (j == x) ? c : mine; }
        if (sum == G) break;
        __builtin_amdgcn_s_sleep(1);
        if ((++sp & 255u) == 0u) { if (xb_ld(&bar[XB_TMO])) break; if (sp > XB_SPIN_CAP) { atomicAdd(&bar[XB_TMO], 1u); break; } }
    }
    nloc = mine > 0u ? mine : 1u; nx = cnt > 0u ? cnt : 1u;
}
__device__ __forceinline__ void xcd_barrier(const XcdBarrier& b) {
    asm volatile("s_waitcnt vmcnt(0)" ::: "memory");
    __syncthreads();
    if (xb_thread0(b.wave)) {
        unsigned* bar = b.bar;
        __builtin_amdgcn_s_waitcnt(0);
        unsigned nloc = b.st[0], nx = b.st[1];
        if (nloc == 0u) { xcd_barrier_complete(bar, xb_xcc_id(), nloc, nx); b.st[0] = nloc; b.st[1] = nx; }
        const unsigned old = xb_add(&bar[XB_XSUB(b.x)], 1u);
        const unsigned gen = old / nloc;
        if (old + 1u == (gen + 1u) * nloc) {
            __builtin_amdgcn_fence(__ATOMIC_RELEASE, "agent");
            asm volatile("s_waitcnt vmcnt(0)" ::: "memory");
            const unsigned og = xb_add(&bar[XB_TOP], 1u);
            const unsigned tg = og / nx;
            if (og + 1u == (tg + 1u) * nx) xb_add(&bar[XB_TOPGEN], 1u);
            else XB_SPIN(xb_ld(&bar[XB_TOPGEN]) == tg, bar);
            __builtin_amdgcn_fence(__ATOMIC_ACQUIRE, "agent");
            xb_add(&bar[XB_XGEN(b.x)], 1u);
            asm volatile("s_waitcnt vmcnt(0)" ::: "memory");
        } else {
            XB_SPIN(xb_ld(&bar[XB_XGEN(b.x)]) == gen, bar);
            __builtin_amdgcn_fence(__ATOMIC_ACQUIRE, "agent");
            asm volatile("s_waitcnt vmcnt(0)" ::: "memory");
        }
    }
    __syncthreads();
}

typedef __bf16 bf16v2_t __attribute__((ext_vector_type(2)));
__device__ __forceinline__ unsigned cvt_pk_bf16(float lo, float hi) { const f32x2 v = {lo, hi}; const bf16v2_t r = __builtin_convertvector(v, bf16v2_t); return __builtin_bit_cast(unsigned, r); }
__device__ __forceinline__ float bf_lo(unsigned u) { return __uint_as_float(u << 16); }
__device__ __forceinline__ float bf_hi(unsigned u) { return __uint_as_float(u & 0xffff0000u); }
__device__ __forceinline__ float shfl_x(float v, int o, int lane) { return __builtin_bit_cast(float, __builtin_amdgcn_ds_bpermute((lane ^ o) << 2, __builtin_bit_cast(int, v))); }
__device__ __forceinline__ float wave_sum(float v, int lane) {
#pragma unroll
    for (int o = 32; o; o >>= 1) v += shfl_x(v, o, lane);
    return v;
}
__device__ __forceinline__ float sigmoidf_(float x) { return 1.0f / (1.0f + __expf(-x)); }
__device__ __forceinline__ float siluf_(float x) { return x / (1.0f + __expf(-x)); }

struct Args { const float* in[28]; float* out; unsigned char* ws; int ph_lo, ph_hi; };
#define CAS __attribute__((address_space(4)))
struct Frame {
    LAS unsigned char* lds; int tid, lane, wave; int G, bid;
    const CAS Args* ka;
    __device__ __forceinline__ const float* in(int i) const { return ka->in[i]; }
    __device__ __forceinline__ unsigned char* ws() const { return ka->ws; }
    __device__ __forceinline__ float* out() const { return ka->out; }
    __device__ __forceinline__ unsigned* ctl() const { return (unsigned*)(ws() + WS_CTL); }
    __device__ __forceinline__ float* MOD() const { return (float*)(ws() + WS_MOD); }
    __device__ __forceinline__ float* WRT() const { return (float*)(ws() + WS_WRT); }
    __device__ __forceinline__ float* TOKG() const { return (float*)(ws() + WS_TOKG); }
    __device__ __forceinline__ int* SLOT() const { return (int*)(ws() + WS_SLOT); }
    __device__ __forceinline__ float* SLOTG() const { return (float*)(ws() + WS_SLOTG); }
    __device__ __forceinline__ float* X() const { return (float*)(ws() + WS_X); }
    __device__ __forceinline__ bf16_t* H() const { return (bf16_t*)(ws() + WS_H); }
    __device__ __forceinline__ bf16_t* U() const { return (bf16_t*)(ws() + WS_U); }
    __device__ __forceinline__ bf16_t* VT() const { return (bf16_t*)(ws() + WS_VT); }
    __device__ __forceinline__ bf16_t* AMIX() const { return (bf16_t*)(ws() + WS_AMIX); }
    __device__ __forceinline__ bf16_t* MIX() const { return (bf16_t*)(ws() + WS_MIX); }
    __device__ __forceinline__ bf16_t* HID() const { return (bf16_t*)(ws() + WS_HID); }
    __device__ __forceinline__ bf16_t* Y2() const { return (bf16_t*)(ws() + WS_Y2); }
    __device__ __forceinline__ bf16_t* EVWIN() const { return (bf16_t*)(ws() + WS_EVWIN); }
    __device__ __forceinline__ bf16_t* EVWOUT() const { return (bf16_t*)(ws() + WS_EVWOUT); }
    __device__ __forceinline__ bf16_t* ODWIN() const { return (bf16_t*)(ws() + WS_ODWIN); }
    __device__ __forceinline__ bf16_t* ODWOUT() const { return (bf16_t*)(ws() + WS_ODWOUT); }
    __device__ __forceinline__ bf16_t* POOLW() const { return (bf16_t*)(ws() + WS_POOLW); }
    __device__ __forceinline__ bf16_t* W13() const { return (bf16_t*)(ws() + WS_W13); }
    __device__ __forceinline__ bf16_t* W2() const { return (bf16_t*)(ws() + WS_W2); }
};

__device__ __forceinline__ Frame phase_frame(const Frame& F0) {
    Frame F = F0;
    int z = 0; asm volatile("" : "+s"(z));
    const int lane = (int)__builtin_amdgcn_mbcnt_hi(~0u, __builtin_amdgcn_mbcnt_lo(~0u, (unsigned)z));
    int w = F0.wave; asm volatile("" : "+s"(w));
    F.lane = lane; F.wave = w; F.tid = w * 64 + lane;
    unsigned long long k = (unsigned long long)F0.ka; asm volatile("" : "+s"(k)); F.ka = (const CAS Args*)k;
    int b = F0.bid; asm volatile("" : "+s"(b)); F.bid = b;
    return F;
}

__device__ __forceinline__ void p0_convert(const Frame& F) {
    LAS float* T = (LAS float*)F.lds;
    const int tid = F.tid;
#pragma unroll 1
    for (int j = 0; j < 8; ++j) {
        const float* src; bf16_t* dst; int nb, K, N, blk, bs, ro; size_t dstb;
        switch (j) {
            case 0: src = F.in(8);  dst = F.EVWIN();  nb = 2;   K = D;   N = EVEN_IN; blk = N;   bs = 0;   ro = 0;   dstb = (size_t)EVEN_IN * D; break;
            case 1: src = F.in(14); dst = F.EVWOUT(); nb = 2;   K = D;   N = D;       blk = N;   bs = 0;   ro = 0;   dstb = (size_t)D * D; break;
            case 2: src = F.in(15); dst = F.ODWIN();  nb = 2;   K = D;   N = ODD_IN;  blk = N;   bs = 0;   ro = 0;   dstb = (size_t)ODD_IN * D; break;
            case 3: src = F.in(19); dst = F.ODWOUT(); nb = 2;   K = D;   N = D;       blk = N;   bs = 0;   ro = 0;   dstb = (size_t)D * D; break;
            case 4: src = F.in(17); dst = F.POOLW();  nb = 8;   K = 256; N = 256;     blk = N;   bs = 0;   ro = 0;   dstb = (size_t)256 * 256; break;
            case 5: src = F.in(24); dst = F.W13();    nb = 128; K = D;   N = FF;      blk = 128; bs = 256; ro = 0;   dstb = (size_t)512 * D; break;
            case 6: src = F.in(25); dst = F.W13();    nb = 128; K = D;   N = FF;      blk = 128; bs = 256; ro = 128; dstb = (size_t)512 * D; break;
            default: src = F.in(26); dst = F.W2();    nb = 128; K = FF;  N = D;       blk = N;   bs = 0;   ro = 0;   dstb = (size_t)D * FF; break;
        }
        const int tk = K / 64, tn = N / 64, per = tk * tn, total = nb * per;
#pragma unroll 1
        for (int t = F.bid; t < total; t += F.G) {
            const int b = t / per, rem = t % per, k0 = (rem / tn) * 64, n0 = (rem % tn) * 64;
            const float* s = src + (size_t)b * K * N;
            bf16_t* d = dst + (size_t)b * dstb;
            { const int kr = tid >> 4, c4 = (tid & 15) * 4;
#pragma unroll
              for (int p = 0; p < 2; ++p) { const int k = kr + 32 * p; const f32x4 v = *(const f32x4*)(s + (size_t)(k0 + k) * N + n0 + c4);
                  T[k * 65 + c4 + 0] = v[0]; T[k * 65 + c4 + 1] = v[1]; T[k * 65 + c4 + 2] = v[2]; T[k * 65 + c4 + 3] = v[3]; } }
            __syncthreads();
            { const int n = tid >> 3, kc = (tid & 7) * 8;
              float v[8];
#pragma unroll
              for (int q = 0; q < 8; ++q) v[q] = T[(kc + q) * 65 + n];
              u32x4 w; w.x = cvt_pk_bf16(v[0], v[1]); w.y = cvt_pk_bf16(v[2], v[3]); w.z = cvt_pk_bf16(v[4], v[5]); w.w = cvt_pk_bf16(v[6], v[7]);
              const int ng = n0 + n, row = (ng / blk) * bs + (ng % blk) + ro;
              *(u32x4*)(d + (size_t)row * K + k0 + kc) = w; }
            __syncthreads();
        }
    }
    for (int i = F.bid * 512 + tid; i < DEPTH * 36 * D; i += F.G * 512) {
        const int l = i / (36 * D), c = (i / D) % 36, k = i % D;
        F.WRT()[i] = (c < 4) ? F.in(20)[((size_t)l * D + k) * 4 + c] : F.in(22)[((size_t)l * D + k) * 32 + (c - 4)];
    }
}

__device__ __forceinline__ void p0_mod(const Frame& F) {
    LAS float* sc = (LAS float*)F.lds;
    LAS float* red = sc + 5 * D;
    for (int i = F.tid; i < 5 * D; i += 512) { const float c = (i < 4 * D) ? F.in(1)[i] : F.in(3)[i - 4 * D]; sc[i] = siluf_(c); }
    __syncthreads();
    const int kq = F.lane >> 4, c4 = (F.lane & 15) * 4;
#pragma unroll 1
    for (int u = F.bid; u < DEPTH * 192; u += F.G) {
        const int l = u / 192, n0 = (u % 192) * 64;
        const float* W = F.in(4) + (size_t)l * D * MODW + n0 + c4;
        f32x4 acc[5];
#pragma unroll
        for (int s = 0; s < 5; ++s) acc[s] = (f32x4){0.f, 0.f, 0.f, 0.f};
#pragma unroll 4
        for (int it = 0; it < 64; ++it) {
            const int k = it * 32 + F.wave * 4 + kq;
            const f32x4 w = *(const f32x4*)(W + (size_t)k * MODW);
#pragma unroll
            for (int s = 0; s < 5; ++s) acc[s] += sc[s * D + k] * w;
        }
#pragma unroll
        for (int s = 0; s < 5; ++s)
#pragma unroll
            for (int i = 0; i < 4; ++i) { float v = acc[s][i]; v += shfl_x(v, 16, F.lane); v += shfl_x(v, 32, F.lane); acc[s][i] = v; }
        if (kq == 0) {
#pragma unroll
            for (int s = 0; s < 5; ++s)
#pragma unroll
                for (int i = 0; i < 4; ++i) red[(F.wave * 5 + s) * 64 + c4 + i] = acc[s][i];
        }
        __syncthreads();
        if (F.tid < 320) { const int s = F.tid >> 6, col = F.tid & 63; float v = F.in(5)[(size_t)l * MODW + n0 + col];
#pragma unroll
            for (int w = 0; w < 8; ++w) v += red[(w * 5 + s) * 64 + col];
            F.MOD()[((size_t)l * 5 + s) * MODW + n0 + col] = v; }
        __syncthreads();
    }
}

template <int MODE>
__device__ __forceinline__ void norm1_phase(const Frame& F, int l) {
    const int nrows = (MODE == 2) ? NLAT : NTOK;
    const float* g = (MODE == 2) ? F.in(27) : F.in(6) + (size_t)l * D;
#pragma unroll 1
    for (int r = F.bid * 8 + F.wave; r < nrows; r += F.G * 8) {
        const int s = r < NLAT ? r / SEQ : 4;
        f32x4 v[8];
        if (MODE == 0) {
            const float* src = r < NLAT ? F.in(0) + (size_t)r * D : F.in(2) + (size_t)(r - NLAT) * D;
#pragma unroll
            for (int j = 0; j < 8; ++j) v[j] = *(const f32x4*)(src + j * 256 + F.lane * 4);
        } else {
            const float* xr = F.X() + (size_t)r * D;
            const float* g5 = F.MOD() + ((size_t)(l - 1) * 5 + s) * MODW + 5 * D;
            const bf16_t* y = F.Y2() + (size_t)r * 2 * D;
#pragma unroll
            for (int j = 0; j < 8; ++j) {
                const int idx = j * 256 + F.lane * 4;
                const f32x4 x = *(const f32x4*)(xr + idx), gg = *(const f32x4*)(g5 + idx);
                const u32x2 a = *(const u32x2*)(y + idx), b = *(const u32x2*)(y + D + idx);
                f32x4 ys; ys[0] = bf_lo(a.x) + bf_lo(b.x); ys[1] = bf_hi(a.x) + bf_hi(b.x); ys[2] = bf_lo(a.y) + bf_lo(b.y); ys[3] = bf_hi(a.y) + bf_hi(b.y);
                v[j] = x + gg * ys;
            }
        }
        float ss = 0.f;
#pragma unroll
        for (int j = 0; j < 8; ++j) ss += v[j][0] * v[j][0] + v[j][1] * v[j][1] + v[j][2] * v[j][2] + v[j][3] * v[j][3];
        ss = wave_sum(ss, F.lane);
        const float rstd = rsqrtf(ss * (1.0f / D) + 1e-6f);
        if (MODE == 2) {
            float* o = F.out() + (size_t)r * D;
#pragma unroll
            for (int j = 0; j < 8; ++j) { const int idx = j * 256 + F.lane * 4; *(f32x4*)(o + idx) = v[j] * rstd * *(const f32x4*)(g + idx); }
        } else {
            float* xr = F.X() + (size_t)r * D;
            const float* sh = F.MOD() + ((size_t)l * 5 + s) * MODW;
            const float* scl = sh + D;
            bf16_t* h = F.H() + (size_t)r * D;
#pragma unroll
            for (int j = 0; j < 8; ++j) {
                const int idx = j * 256 + F.lane * 4;
                *(f32x4*)(xr + idx) = v[j];
                const f32x4 hv = v[j] * rstd * *(const f32x4*)(g + idx) * (1.0f + *(const f32x4*)(scl + idx)) + *(const f32x4*)(sh + idx);
                u32x2 w; w.x = cvt_pk_bf16(hv[0], hv[1]); w.y = cvt_pk_bf16(hv[2], hv[3]);
                *(u32x2*)(h + idx) = w;
            }
        }
    }
}

__device__ __forceinline__ void norm2_router_phase(const Frame& F, int l) {
    const int nrows = (l == DEPTH - 1) ? NLAT : NTOK;
    LAS float* lg = (LAS float*)F.lds + F.wave * (4 * 36);
    const float* g2 = F.in(7) + (size_t)l * D;
    const float* wrt = F.WRT() + (size_t)l * 36 * D;
    unsigned* cnt = F.ctl() + CW_CNT + l * 32;
#pragma unroll 1
    for (int r0 = (F.bid * 8 + F.wave) * 4; r0 < nrows; r0 += F.G * 8 * 4) {
        const int s = r0 < NLAT ? r0 / SEQ : 4;
        const float* sh = F.MOD() + ((size_t)l * 5 + s) * MODW + 3 * D;
        const float* scl = sh + D;
        f32x4 hv[4][8];
#pragma unroll
        for (int rr = 0; rr < 4; ++rr) {
            const float* xr = F.X() + (size_t)(r0 + rr) * D;
            float ss = 0.f;
#pragma unroll
            for (int j = 0; j < 8; ++j) { hv[rr][j] = *(const f32x4*)(xr + j * 256 + F.lane * 4); ss += hv[rr][j][0] * hv[rr][j][0] + hv[rr][j][1] * hv[rr][j][1] + hv[rr][j][2] * hv[rr][j][2] + hv[rr][j][3] * hv[rr][j][3]; }
            ss = wave_sum(ss, F.lane);
            const float rstd = rsqrtf(ss * (1.0f / D) + 1e-6f);
            bf16_t* h = F.H() + (size_t)(r0 + rr) * D;
#pragma unroll
            for (int j = 0; j < 8; ++j) {
                const int idx = j * 256 + F.lane * 4;
                hv[rr][j] = hv[rr][j] * rstd * *(const f32x4*)(g2 + idx) * (1.0f + *(const f32x4*)(scl + idx)) + *(const f32x4*)(sh + idx);
                u32x2 w; w.x = cvt_pk_bf16(hv[rr][j][0], hv[rr][j][1]); w.y = cvt_pk_bf16(hv[rr][j][2], hv[rr][j][3]);
                *(u32x2*)(h + idx) = w;
            }
        }
#pragma unroll 1
        for (int c = 0; c < 36; ++c) {
            const float* wc = wrt + (size_t)c * D;
            float d0 = 0.f, d1 = 0.f, d2 = 0.f, d3 = 0.f;
#pragma unroll
            for (int j = 0; j < 8; ++j) {
                const f32x4 w = *(const f32x4*)(wc + j * 256 + F.lane * 4);
                d0 += hv[0][j][0] * w[0] + hv[0][j][1] * w[1] + hv[0][j][2] * w[2] + hv[0][j][3] * w[3];
                d1 += hv[1][j][0] * w[0] + hv[1][j][1] * w[1] + hv[1][j][2] * w[2] + hv[1][j][3] * w[3];
                d2 += hv[2][j][0] * w[0] + hv[2][j][1] * w[1] + hv[2][j][2] * w[2] + hv[2][j][3] * w[3];
                d3 += hv[3][j][0] * w[0] + hv[3][j][1] * w[1] + hv[3][j][2] * w[2] + hv[3][j][3] * w[3];
            }
            d0 = wave_sum(d0, F.lane); d1 = wave_sum(d1, F.lane); d2 = wave_sum(d2, F.lane); d3 = wave_sum(d3, F.lane);
            if (F.lane == 0) { lg[0 * 36 + c] = d0; lg[1 * 36 + c] = d1; lg[2 * 36 + c] = d2; lg[3 * 36 + c] = d3; }
        }
        __builtin_amdgcn_fence(__ATOMIC_RELEASE, "workgroup");
        __builtin_amdgcn_wave_barrier();
        __builtin_amdgcn_fence(__ATOMIC_ACQUIRE, "workgroup");
        if (F.lane < 4) {
            const int rr = F.lane, r = r0 + rr;
            const LAS float* L = lg + rr * 36;
            float gl[4]; float gm = -3.0e38f; int gi = 0;
#pragma unroll
            for (int q = 0; q < 4; ++q) { gl[q] = L[q] + F.in(21)[l * 4 + q]; if (gl[q] > gm) { gm = gl[q]; gi = q; } }
            float gs = 0.f;
#pragma unroll
            for (int q = 0; q < 4; ++q) gs += __expf(gl[q] - gm);
            const float gp = 1.0f / gs;
            float el[8]; float m1 = -3.0e38f; int i1 = 0;
#pragma unroll
            for (int q = 0; q < 8; ++q) { el[q] = L[4 + gi * 8 + q] + F.in(23)[l * 32 + gi * 8 + q]; if (el[q] > m1) { m1 = el[q]; i1 = q; } }
            float m2 = -3.0e38f; int i2 = 0;
#pragma unroll
            for (int q = 0; q < 8; ++q) { if (q != i1 && el[q] > m2) { m2 = el[q]; i2 = q; } }
            const float e2 = __expf(m2 - m1);
            const float w1 = gp / (1.0f + e2), w2 = gp * e2 / (1.0f + e2);
            const int ex1 = gi * 8 + i1, ex2 = gi * 8 + i2;
            const unsigned p1 = atomicAdd(cnt + ex1, 1u), p2 = atomicAdd(cnt + ex2, 1u);
            F.SLOT()[(size_t)ex1 * SLOT_CAP + p1] = r * 2;
            F.SLOT()[(size_t)ex2 * SLOT_CAP + p2] = r * 2 + 1;
            F.SLOTG()[(size_t)ex1 * SLOT_CAP + p1] = w1; F.SLOTG()[(size_t)ex2 * SLOT_CAP + p2] = w2;
        }
        __builtin_amdgcn_wave_barrier();
    }
}

__device__ __forceinline__ void sgemm_core(const bf16_t* (&ap)[4], const bf16_t* bp0, const bf16_t* bp1, int K, f32x4 (&a)[4], f32x4 (&b)[4]) {
#pragma unroll
    for (int m = 0; m < 4; ++m) { a[m] = (f32x4){0.f, 0.f, 0.f, 0.f}; b[m] = (f32x4){0.f, 0.f, 0.f, 0.f}; }
#pragma unroll 2
    for (int k0 = 0; k0 < K; k0 += 32) {
        const bf16x8 b0 = *(const bf16x8*)(bp0 + k0), b1 = *(const bf16x8*)(bp1 + k0);
        bf16x8 af[4];
#pragma unroll
        for (int m = 0; m < 4; ++m) af[m] = *(const bf16x8*)(ap[m] + k0);
#pragma unroll
        for (int m = 0; m < 4; ++m) { a[m] = __builtin_amdgcn_mfma_f32_16x16x32_bf16(b0, af[m], a[m], 0, 0, 0); b[m] = __builtin_amdgcn_mfma_f32_16x16x32_bf16(b1, af[m], b[m], 0, 0, 0); }
    }
}

template <class Epi>
__device__ __forceinline__ void sgemm_phase(const Frame& F, const bf16_t* A, int lda, int a_pn_off, const bf16_t* Bt, int ldb, int M, int N, int K, const Epi& E) {
    const int fr = F.lane & 15, fq = F.lane >> 4;
    const int nM = M / 64, nN = N / 256, total = nM * nN;
#pragma unroll 1
    for (int u = F.bid; u < total; u += F.G) {
        const int pm = u / nN, pn = u % nN;
        const bf16_t* ap[4];
#pragma unroll
        for (int m = 0; m < 4; ++m) ap[m] = A + (size_t)(pm * 64 + m * 16 + fr) * lda + pn * a_pn_off + 8 * fq;
        const bf16_t* bp0 = Bt + (size_t)(pn * 256 + F.wave * 16 + fr) * ldb + 8 * fq;
        const bf16_t* bp1 = bp0 + (size_t)128 * ldb;
        f32x4 a[4], b[4];
        sgemm_core(ap, bp0, bp1, K, a, b);
#pragma unroll
        for (int m = 0; m < 4; ++m) E(pm * 64 + m * 16 + fr, pn * 256 + F.wave * 16 + 4 * fq, a[m], b[m]);
    }
}

__device__ __forceinline__ void st_bf16x4(bf16_t* p, f32x4 v) { u32x2 w; w.x = cvt_pk_bf16(v[0], v[1]); w.y = cvt_pk_bf16(v[2], v[3]); *(u32x2*)p = w; }

struct EpiU {
    bf16_t* U; int ldu; bf16_t* VT; int odd;
    __device__ __forceinline__ void operator()(int row, int col, f32x4 a, f32x4 b) const {
        st_bf16x4(U + (size_t)row * ldu + col, a); st_bf16x4(U + (size_t)row * ldu + col + 128, b);
        if (odd && col >= 2048 && col < 3072) {
#pragma unroll
            for (int i = 0; i < 4; ++i) {
                VT[(size_t)(col - 2048 + i) * NTOK + row] = (bf16_t)(cvt_pk_bf16(a[i], 0.f) & 0xffffu);
                VT[(size_t)(col - 2048 + 128 + i) * NTOK + row] = (bf16_t)(cvt_pk_bf16(b[i], 0.f) & 0xffffu);
            }
        }
    }
};
struct EpiPool {
    bf16_t* AMIX; const float* scale;
    __device__ __forceinline__ void operator()(int row, int col, f32x4 a, f32x4 b) const {
        st_bf16x4(AMIX + (size_t)row * D + 1024 + col, a * *(const f32x4*)(scale + col));
        st_bf16x4(AMIX + (size_t)row * D + 1024 + col + 128, b * *(const f32x4*)(scale + col + 128));
    }
};
struct EpiRes {
    float* X; const float* MODl;
    __device__ __forceinline__ void operator()(int row, int col, f32x4 a, f32x4 b) const {
        const int s = row < NLAT ? row / SEQ : 4;
        const float* g = MODl + (size_t)s * MODW;
        float* x = X + (size_t)row * D + col;
        *(f32x4*)x = *(const f32x4*)x + *(const f32x4*)(g + col) * a;
        *(f32x4*)(x + 128) = *(const f32x4*)(x + 128) + *(const f32x4*)(g + col + 128) * b;
    }
};

__device__ __forceinline__ void conv_phase(const Frame& F, int je) {
    LAS bf16_t* zt = (LAS bf16_t*)F.lds;
    LAS float* part = (LAS float*)(F.lds + 46 * 1024 * 2);
    LAS float* stat = part + 16 * 8 * 2;
    const int ch = 2 * F.tid;
    const float* cw = F.in(9) + (size_t)je * 3 * 1024;
    const float* dw = F.in(10) + (size_t)je * 31 * 1024;
    const f32x2 dwb = *(const f32x2*)(F.in(11) + (size_t)je * 1024 + ch);
    const f32x2 lng = *(const f32x2*)(F.in(12) + (size_t)je * 1024 + ch);
    const f32x2 lnb = *(const f32x2*)(F.in(13) + (size_t)je * 1024 + ch);
    const f32x2 ca0 = *(const f32x2*)(cw + ch), ca1 = *(const f32x2*)(cw + 1024 + ch), ca2 = *(const f32x2*)(cw + 2048 + ch);
    constexpr int UL = NLAT / 16, UC = NCTX / 16;
#pragma unroll 1
    for (int u = F.bid; u < UL + UC; u += F.G) {
        int srow0, L, t0;
        if (u < UL) { const int b = u / (SEQ / 16); srow0 = b * SEQ; L = SEQ; t0 = (u % (SEQ / 16)) * 16; }
        else { const int v = u - UL, b = v / (CTXL / 16); srow0 = NLAT + b * CTXL; L = CTXL; t0 = (v % (CTXL / 16)) * 16; }
        const bf16_t* Ub = F.U() + (size_t)srow0 * EVEN_IN;
#pragma unroll 2
        for (int rr = 0; rr < 46; ++rr) {
            const int t = t0 - 15 + rr; unsigned zz = 0u;
            if (t >= 0 && t < L) {
                const unsigned ga = *(const unsigned*)(Ub + (size_t)t * EVEN_IN + 3072 + ch), gb = *(const unsigned*)(Ub + (size_t)t * EVEN_IN + 4096 + ch);
                zz = cvt_pk_bf16(bf_lo(ga) * sigmoidf_(bf_lo(gb)), bf_hi(ga) * sigmoidf_(bf_hi(gb)));
            }
            *(LAS unsigned*)(zt + rr * 1024 + ch) = zz;
        }
        float z0[16], z1[16];
#pragma unroll
        for (int t = 0; t < 16; ++t) { z0[t] = dwb.x; z1[t] = dwb.y; }
#pragma unroll 1
        for (int jj = 0; jj < 31; ++jj) {
            const f32x2 w = *(const f32x2*)(dw + (size_t)jj * 1024 + ch);
            const LAS bf16_t* zp = zt + jj * 1024 + ch;
#pragma unroll
            for (int t = 0; t < 16; ++t) { const unsigned zz = *(const LAS unsigned*)(zp + t * 1024); z0[t] += w.x * bf_lo(zz); z1[t] += w.y * bf_hi(zz); }
        }
#pragma unroll
        for (int t = 0; t < 16; ++t) {
            float s1 = z0[t] + z1[t], s2 = z0[t] * z0[t] + z1[t] * z1[t];
            s1 = wave_sum(s1, F.lane); s2 = wave_sum(s2, F.lane);
            if (F.lane == 0) { part[(t * 8 + F.wave) * 2] = s1; part[(t * 8 + F.wave) * 2 + 1] = s2; }
        }
        __syncthreads();
        if (F.tid < 16) { float s1 = 0.f, s2 = 0.f;
#pragma unroll
            for (int w = 0; w < 8; ++w) { s1 += part[(F.tid * 8 + w) * 2]; s2 += part[(F.tid * 8 + w) * 2 + 1]; }
            const float mu = s1 * (1.0f / 1024.0f); float var = s2 * (1.0f / 1024.0f) - mu * mu; var = var < 0.f ? 0.f : var;
            stat[F.tid * 2] = mu; stat[F.tid * 2 + 1] = rsqrtf(var + 1e-5f); }
        __syncthreads();
        bf16_t* Ab = F.AMIX() + (size_t)(srow0 + t0) * D;
#pragma unroll
        for (int t = 0; t < 16; ++t) {
            const float mu = stat[t * 2], rs = stat[t * 2 + 1];
            const float y0 = (z0[t] - mu) * rs * lng.x + lnb.x, y1 = (z1[t] - mu) * rs * lng.y + lnb.y;
            *(unsigned*)(Ab + (size_t)t * D + 1024 + ch) = cvt_pk_bf16(siluf_(y0), siluf_(y1));
        }
        {
            float p0 = 0.f, p1 = 0.f, c0 = 0.f, c1 = 0.f;
            if (t0 - 1 >= 0) { const unsigned cg = *(const unsigned*)(Ub + (size_t)(t0 - 1) * EVEN_IN + 1024 + ch), xa = *(const unsigned*)(Ub + (size_t)(t0 - 1) * EVEN_IN + 2048 + ch); p0 = bf_lo(cg) * bf_lo(xa); p1 = bf_hi(cg) * bf_hi(xa); }
            { const unsigned cg = *(const unsigned*)(Ub + (size_t)t0 * EVEN_IN + 1024 + ch), xa = *(const unsigned*)(Ub + (size_t)t0 * EVEN_IN + 2048 + ch); c0 = bf_lo(cg) * bf_lo(xa); c1 = bf_hi(cg) * bf_hi(xa); }
#pragma unroll
            for (int t = 0; t < 16; ++t) {
                const int tn = t0 + t + 1; float n0 = 0.f, n1 = 0.f;
                if (tn < L) { const unsigned cg = *(const unsigned*)(Ub + (size_t)tn * EVEN_IN + 1024 + ch), xa = *(const unsigned*)(Ub + (size_t)tn * EVEN_IN + 2048 + ch); n0 = bf_lo(cg) * bf_lo(xa); n1 = bf_hi(cg) * bf_hi(xa); }
                const unsigned bg = *(const unsigned*)(Ub + (size_t)(t0 + t) * EVEN_IN + ch);
                const float y0 = bf_lo(bg) * (ca0.x * p0 + ca1.x * c0 + ca2.x * n0), y1 = bf_hi(bg) * (ca0.y * p1 + ca1.y * c1 + ca2.y * n1);
                *(unsigned*)(Ab + (size_t)t * D + ch) = cvt_pk_bf16(y0, y1);
                p0 = c0; p1 = c1; c0 = n0; c1 = n1;
            }
        }
        __syncthreads();
    }
}

__device__ __forceinline__ void attn_unit(const Frame& F, int jo, int qrow0, int qcol0, int kwrow0, int kcrow0, int h, int r, int r_start) {
    constexpr int PLS = 776, MT = 2;
    LAS bf16_t* Pl = (LAS bf16_t*)F.lds;
    LAS float* pm = (LAS float*)(F.lds + 32 * PLS * 2);
    LAS float* ps = pm + 32 * 8;
    const int w = F.wave, fr = F.lane & 15, fq = F.lane >> 4;
    const bool has_win = kwrow0 >= 0;
    const bf16_t* U = F.U();
    f32x4 acc[MT][6];
#pragma unroll
    for (int m = 0; m < MT; ++m)
#pragma unroll
        for (int nt = 0; nt < 6; ++nt) acc[m][nt] = (f32x4){0.f, 0.f, 0.f, 0.f};
    {
        const bf16_t* qp = U + (size_t)(qrow0 + fr) * ODD_IN + h * 128 + 8 * fq;
        const bf16_t* kwp = U + (size_t)((has_win ? kwrow0 : kcrow0) + 64 * w + fr) * ODD_IN + 1024 + h * 128 + 8 * fq;
        const bf16_t* kcp = U + (size_t)(kcrow0 + 32 * w + fr) * ODD_IN + 1024 + h * 128 + 8 * fq;
#pragma unroll
        for (int kk = 0; kk < 4; ++kk) {
            bf16x8 qf[MT];
#pragma unroll
            for (int m = 0; m < MT; ++m) qf[m] = *(const bf16x8*)(qp + (size_t)(16 * m) * ODD_IN + 32 * kk);
#pragma unroll
            for (int nt = 0; nt < 6; ++nt) {
                if (nt < 4 && !has_win) continue;
                const bf16x8 kf = nt < 4 ? *(const bf16x8*)(kwp + (size_t)(16 * nt) * ODD_IN + 32 * kk) : *(const bf16x8*)(kcp + (size_t)(16 * (nt - 4)) * ODD_IN + 32 * kk);
#pragma unroll
                for (int m = 0; m < MT; ++m) acc[m][nt] = __builtin_amdgcn_mfma_f32_16x16x32_bf16(kf, qf[m], acc[m][nt], 0, 0, 0);
            }
        }
    }
    const float scale = 0.08838834764831845f;
    const float* rpb = F.in(16) + ((size_t)(jo * 8 + h) * 15 + ((r_start + w) - r + 7)) * 31;
#pragma unroll
    for (int m = 0; m < MT; ++m) {
        const int ql = 16 * m + fr, qc = qcol0 + ql; int cs = qc - 8; cs = cs < 0 ? 0 : (cs > 48 ? 48 : cs);
        float mx = -3.0e38f;
#pragma unroll
        for (int nt = 0; nt < 6; ++nt)
#pragma unroll
            for (int i = 0; i < 4; ++i) {
                float sv;
                if (nt < 4) {
                    if (has_win) {
                        const int kcol = 16 * nt + 4 * fq + i;
                        int dc = kcol - qc; dc = dc < -15 ? -15 : (dc > 15 ? 15 : dc);
                        const int dd = kcol - cs;
                        const unsigned inval = (unsigned)((dd | (15 - dd)) >> 31);
                        const unsigned bits = __float_as_uint(acc[m][nt][i] * scale + rpb[dc + 15]);
                        sv = __uint_as_float((bits & ~inval) | (0xF149F2CAu & inval));
                    } else sv = -1.0e30f;
                } else sv = acc[m][nt][i] * scale;
                acc[m][nt][i] = sv; mx = fmaxf(mx, sv);
            }
        mx = fmaxf(mx, shfl_x(mx, 16, F.lane)); mx = fmaxf(mx, shfl_x(mx, 32, F.lane));
        if (fq == 0) pm[ql * 8 + w] = mx;
    }
    __syncthreads();
#pragma unroll
    for (int m = 0; m < MT; ++m) {
        const int ql = 16 * m + fr;
        const f32x4 ma = *(const LAS f32x4*)(pm + ql * 8), mb = *(const LAS f32x4*)(pm + ql * 8 + 4);
        const float M = fmaxf(fmaxf(fmaxf(ma[0], ma[1]), fmaxf(ma[2], ma[3])), fmaxf(fmaxf(mb[0], mb[1]), fmaxf(mb[2], mb[3])));
        float sum = 0.f;
#pragma unroll
        for (int nt = 0; nt < 6; ++nt) {
            if (nt < 4 && !has_win) continue;
            float p[4];
#pragma unroll
            for (int i = 0; i < 4; ++i) { p[i] = __expf(acc[m][nt][i] - M); sum += p[i]; }
            const int kidx = nt < 4 ? 64 * w + 16 * nt + 4 * fq : 512 + 32 * w + 16 * (nt - 4) + 4 * fq;
            u32x2 pk; pk.x = cvt_pk_bf16(p[0], p[1]); pk.y = cvt_pk_bf16(p[2], p[3]);
            *(LAS u32x2*)(Pl + ql * PLS + kidx) = pk;
        }
        sum += shfl_x(sum, 16, F.lane); sum += shfl_x(sum, 32, F.lane);
        if (fq == 0) ps[ql * 8 + w] = sum;
    }
    __syncthreads();
    f32x4 o[MT];
#pragma unroll
    for (int m = 0; m < MT; ++m) o[m] = (f32x4){0.f, 0.f, 0.f, 0.f};
    const bf16_t* vt = F.VT() + (size_t)(h * 128 + 16 * w + fr) * NTOK + 8 * fq;
#pragma unroll 4
    for (int kk = 0; kk < 24; ++kk) {
        if (kk < 16 && !has_win) continue;
        const int tokbase = kk < 16 ? kwrow0 + 32 * kk : kcrow0 + 32 * (kk - 16);
        const bf16x8 vf = *(const bf16x8*)(vt + tokbase);
#pragma unroll
        for (int m = 0; m < MT; ++m) { const bf16x8 pf = *(const LAS bf16x8*)(Pl + (16 * m + fr) * PLS + 32 * kk + 8 * fq); o[m] = __builtin_amdgcn_mfma_f32_16x16x32_bf16(vf, pf, o[m], 0, 0, 0); }
    }
#pragma unroll
    for (int m = 0; m < MT; ++m) {
        const int ql = 16 * m + fr;
        const f32x4 sa = *(const LAS f32x4*)(ps + ql * 8), sb = *(const LAS f32x4*)(ps + ql * 8 + 4);
        const float inv = 1.0f / (((sa[0] + sa[1]) + (sa[2] + sa[3])) + ((sb[0] + sb[1]) + (sb[2] + sb[3])));
        st_bf16x4(F.AMIX() + (size_t)(qrow0 + ql) * D + h * 128 + 16 * w + 4 * fq, o[m] * inv);
    }
    __syncthreads();
}

__device__ __forceinline__ void attn_mix_phase(const Frame& F, int l) {
    const int jo = l >> 1;
    const bool last = (l == DEPTH - 1);
    const int nA = NB * 32 * 8 * 2, nC = last ? 0 : NB * 8 * 8, nMix = (last ? NLAT : NTOK) / 32;
#pragma unroll 1
    for (int u = F.bid; u < nA + nC + nMix; u += F.G) {
        if (u < nA + nC) {
            int qrow0, qcol0, kwrow0, kcrow0, h, r, rs;
            if (u < nA) {
                h = u & 7; const int half = (u >> 3) & 1; r = (u >> 4) & 31; const int b = u >> 9;
                rs = r - 4; rs = rs < 0 ? 0 : (rs > 24 ? 24 : rs);
                qcol0 = half * 32; qrow0 = b * SEQ + r * 64 + qcol0; kwrow0 = b * SEQ + rs * 64; kcrow0 = NLAT + b * CTXL;
            } else {
                const int v = u - nA; h = v & 7; const int qb = (v >> 3) & 7, b = v >> 6;
                qcol0 = 0; qrow0 = NLAT + b * CTXL + qb * 32; kwrow0 = -1; kcrow0 = NLAT + b * CTXL; r = 0; rs = 0;
            }
            attn_unit(F, jo, qrow0, qcol0, kwrow0, kcrow0, h, r, rs);
        } else {
            const int row0 = (u - nA - nC) * 32;
            int srow0, L;
            if (row0 < NLAT) { srow0 = (row0 / SEQ) * SEQ; L = SEQ; } else { srow0 = NLAT + ((row0 - NLAT) / CTXL) * CTXL; L = CTXL; }
            const int ch = 2 * F.tid, g = F.tid >> 7, win = 2 << g;
            const bf16_t* Ub = F.U() + (size_t)srow0 * ODD_IN + 3072 + ch;
#pragma unroll 1
            for (int tt = 0; tt < 32; ++tt) {
                const int t = row0 - srow0 + tt;
                int lo = t - win / 2; const int hi0 = lo + win - 1; lo = lo < 0 ? 0 : lo; const int hi = hi0 > L - 1 ? L - 1 : hi0;
                float s0 = 0.f, s1 = 0.f;
                for (int q = lo; q <= hi; ++q) { const unsigned pv = *(const unsigned*)(Ub + (size_t)q * ODD_IN); s0 += bf_lo(pv); s1 += bf_hi(pv); }
                const unsigned pc = *(const unsigned*)(Ub + (size_t)t * ODD_IN);
                const float inv = 1.0f / (float)(hi - lo + 1);
                *(unsigned*)(F.MIX() + (size_t)(row0 + tt) * 1024 + ch) = cvt_pk_bf16(s0 * inv - bf_lo(pc), s1 * inv - bf_hi(pc));
            }
        }
    }
}

namespace pg8 {
constexpr int BM = 256, BK = 64, HALF = 128, HTB = HALF * BK * 2, STAGE_BYTES = 8 * HTB, NXCD = 8, WGM = 8;
__device__ __forceinline__ int lds_byte(int r, int c) { const int st = (r >> 4) * 2 + (c >> 5), rr = r & 15, cc = c & 31, ob = rr * 64 + cc * 2; return st * 1024 + (ob ^ (((ob >> 9) & 1) << 5)); }
__device__ __forceinline__ void stage_rc(int b, int& R, int& C) { const int st = b / 1024, sb = b % 1024, swz = sb ^ (((sb >> 9) & 1) << 5); R = (st >> 1) * 16 + swz / 64; C = (st & 1) * 32 + (swz % 64) / 2; }
struct Unit { int pm, pn, aux; };

struct DenseSched {
    const char* A; const char* Bt; int lda, ldb, a_pn_off; int nM, nN, nwg, G, c;
    __device__ __forceinline__ void init(const void* A_, int lda_, int a_pn_off_, const void* Bt_, int ldb_, int M, int N, int G_, int c_) {
        A = (const char*)A_; Bt = (const char*)Bt_; lda = lda_; ldb = ldb_; a_pn_off = a_pn_off_; nM = M / BM; nN = N / BM; nwg = nM * nN; G = G_; c = c_; }
    __device__ __forceinline__ bool next(int i, Unit& u) const {
        const long L = (long)i * G + c; if (L >= nwg) return false;
        int wgid = (int)L; { const int q = nwg / NXCD, r = nwg % NXCD, xcd = wgid % NXCD, off = wgid / NXCD; wgid = (xcd < r ? xcd * (q + 1) : r * (q + 1) + (xcd - r) * q) + off; }
        const int nig = WGM * nN, gid = wgid / nig, fm = gid * WGM, gsz = (nM - fm) < WGM ? (nM - fm) : WGM;
        u.pm = fm + ((wgid % nig) % gsz); u.pn = (wgid % nig) / gsz; u.aux = 0; return true;
    }
    __device__ __forceinline__ const char* a_ptr(const Unit& u) const { return A + ((size_t)u.pm * BM * lda + (size_t)u.pn * a_pn_off) * 2; }
    __device__ __forceinline__ const char* b_ptr(const Unit& u) const { return Bt + (size_t)u.pn * BM * ldb * 2; }
    __device__ __forceinline__ void a_gather(const Unit&, const int (&)[2], const int (&)[2], unsigned (&)[2][2]) const {}
};

template <class Epi, class Sched, bool GATHER>
__device__ __forceinline__ void gemm_phase(LAS unsigned char* lds, const int tid, const int K, const int lda, const int ldb, const Sched& S, const Epi& E) {
    const int wid = __builtin_amdgcn_readfirstlane(tid >> 6), lane = tid & 63, wr = wid >> 2, wc = wid & 3, fr = lane & 15, fq = lane >> 4;
    const int nt = K / BK;
    unsigned voffA[2], voffB[2]; int RA[2], CA[2];
#pragma unroll
    for (int i = 0; i < 2; ++i) { int R, C; stage_rc(tid * 16 + i * 8192, R, C); RA[i] = R; CA[i] = C;
        voffA[i] = (unsigned)(R * lda + C) * 2u; voffB[i] = (unsigned)(R * ldb + C) * 2u; }
    const size_t kstep = (size_t)(BK * 2);
    const size_t hstepA = (size_t)HALF * lda * 2, hstepB = (size_t)HALF * ldb * 2;
    const unsigned ldsw = (unsigned)wid * 1024u;
    const int aoff = lds_byte(wr * 64 + fr, fq * 8), boff = lds_byte(wc * 32 + fr, fq * 8);
#define PG8_SA(b, h) (((b) * 2 + (h)) * HTB)
#define PG8_SB(b, h) ((4 + (b) * 2 + (h)) * HTB)
#define PG8_STAGE(bufoff, gbase, voff) do { _Pragma("unroll") for (int _i = 0; _i < 2; ++_i) \
        __builtin_amdgcn_global_load_lds((const unsigned*)((const char*)(gbase) + (voff)[_i]), (LAS unsigned*)(lds + (bufoff) + ldsw + _i * 8192), 16, 0, 0); } while (0)
#define PG8_STAGE_A(b, h, kptr, G) do { if constexpr (GATHER) PG8_STAGE(PG8_SA(b, h), kptr, (G)[h]); else PG8_STAGE(PG8_SA(b, h), (kptr) + (h) * hstepA, voffA); } while (0)
#define PG8_LDA(dst, b, h) do { _Pragma("unroll") for (int m = 0; m < 4; ++m) _Pragma("unroll") for (int k = 0; k < 2; ++k) dst[m][k] = *(const LAS bf16x8*)(lds + PG8_SA(b, h) + aoff + m * 2048 + k * 1024); } while (0)
#define PG8_LDB(dst, b, h) do { _Pragma("unroll") for (int n = 0; n < 2; ++n) _Pragma("unroll") for (int k = 0; k < 2; ++k) dst[n][k] = *(const LAS bf16x8*)(lds + PG8_SB(b, h) + boff + n * 2048 + k * 1024); } while (0)
#define PG8_MMA(ai, bj, At, Bt) do { __builtin_amdgcn_s_setprio(1); _Pragma("unroll") for (int m = 0; m < 4; ++m) _Pragma("unroll") for (int n = 0; n < 2; ++n) _Pragma("unroll") for (int k = 0; k < 2; ++k) \
        acc[ai][bj][m][n] = __builtin_amdgcn_mfma_f32_16x16x32_bf16(Bt[n][k], At[m][k], acc[ai][bj][m][n], 0, 0, 0); __builtin_amdgcn_s_setprio(0); } while (0)
#define PG8_WAIT_V(n) asm volatile("s_waitcnt vmcnt(" #n ")" ::: "memory")
#define PG8_WAIT_L(n) asm volatile("s_waitcnt lgkmcnt(" #n ")" ::: "memory")
#define PG8_BAR __builtin_amdgcn_s_barrier()
#define PG8_SCHED __builtin_amdgcn_sched_barrier(0)
    Unit cur, nxt; int ui = 0;
    if (!S.next(0, cur)) return;
    f32x4 acc[2][2][4][2];
#pragma unroll
    for (int a = 0; a < 2; ++a)
#pragma unroll
        for (int b = 0; b < 2; ++b)
#pragma unroll
            for (int m = 0; m < 4; ++m)
#pragma unroll
                for (int n = 0; n < 2; ++n) acc[a][b][m][n] = (f32x4){0.f, 0.f, 0.f, 0.f};
    bf16x8 At[4][2], B0[2][2], B1[2][2];
    const char* cA = S.a_ptr(cur); const char* cB = S.b_ptr(cur);
    unsigned gcur[2][2] = {{0u, 0u}, {0u, 0u}}, gnx[2][2] = {{0u, 0u}, {0u, 0u}};
    if constexpr (GATHER) S.a_gather(cur, RA, CA, gcur);
    PG8_STAGE(PG8_SB(0, 0), cB, voffB); PG8_STAGE_A(0, 0, cA, gcur); PG8_STAGE(PG8_SB(0, 1), cB + hstepB, voffB); PG8_STAGE_A(0, 1, cA, gcur);
    if (wr == 1) PG8_BAR;
    PG8_WAIT_V(4); PG8_BAR;
    PG8_STAGE(PG8_SB(1, 0), cB + kstep, voffB); PG8_STAGE_A(1, 0, cA + kstep, gcur); PG8_STAGE(PG8_SB(1, 1), cB + hstepB + kstep, voffB);
    PG8_WAIT_V(6); PG8_BAR;
    for (;;) {
        const bool has_next = S.next(ui + 1, nxt);
        const char* nA = has_next ? S.a_ptr(nxt) : cA; const char* nB = has_next ? S.b_ptr(nxt) : cB;
        if constexpr (GATHER) { if (has_next) S.a_gather(nxt, RA, CA, gnx); else {
#pragma unroll
            for (int h = 0; h < 2; ++h)
#pragma unroll
                for (int i = 0; i < 2; ++i) gnx[h][i] = gcur[h][i]; } }
#pragma unroll 1
        for (int t = 0; t < nt; t += 2) {
            const bool last = (t == nt - 2);
            const char* a1 = cA + (size_t)(t + 1) * kstep;
            const char* a2 = last ? nA : cA + (size_t)(t + 2) * kstep; const char* b2 = last ? nB : cB + (size_t)(t + 2) * kstep;
            const char* a3 = a2 + kstep; const char* b3 = b2 + kstep;
            unsigned g2[2][2];
#pragma unroll
            for (int h = 0; h < 2; ++h)
#pragma unroll
                for (int i = 0; i < 2; ++i) g2[h][i] = last ? gnx[h][i] : gcur[h][i];
            PG8_LDB(B0, 0, 0); PG8_SCHED; PG8_LDA(At, 0, 0); PG8_STAGE_A(1, 1, a1, gcur);
            PG8_WAIT_L(8); PG8_BAR; PG8_WAIT_L(0); PG8_MMA(0, 0, At, B0); PG8_BAR; PG8_SCHED;
            PG8_LDB(B1, 0, 1); PG8_STAGE(PG8_SB(0, 0), b2, voffB);
            PG8_BAR; PG8_WAIT_L(0); PG8_MMA(0, 1, At, B1); PG8_BAR;
            PG8_LDA(At, 0, 1); PG8_STAGE_A(0, 0, a2, g2);
            PG8_BAR; PG8_WAIT_L(0); PG8_MMA(1, 0, At, B0); PG8_BAR; PG8_SCHED;
            PG8_STAGE(PG8_SB(0, 1), b2 + hstepB, voffB);
            PG8_WAIT_V(6); PG8_BAR; PG8_MMA(1, 1, At, B1); PG8_BAR;
            PG8_LDB(B0, 1, 0); PG8_SCHED; PG8_LDA(At, 1, 0); PG8_STAGE_A(0, 1, a2, g2);
            PG8_WAIT_L(8); PG8_BAR; PG8_WAIT_L(0); PG8_MMA(0, 0, At, B0); PG8_BAR; PG8_SCHED;
            PG8_LDB(B1, 1, 1); PG8_STAGE(PG8_SB(1, 0), b3, voffB);
            PG8_BAR; PG8_WAIT_L(0); PG8_MMA(0, 1, At, B1); PG8_BAR;
            PG8_LDA(At, 1, 1); PG8_STAGE_A(1, 0, a3, g2);
            PG8_BAR; PG8_WAIT_L(0); PG8_MMA(1, 0, At, B0); PG8_BAR; PG8_SCHED;
            PG8_STAGE(PG8_SB(1, 1), b3 + hstepB, voffB);
            PG8_WAIT_V(6); PG8_BAR; PG8_MMA(1, 1, At, B1); PG8_BAR;
        }
        E(acc, cur, wr, wc, fr, fq);
        if (!has_next) break;
#pragma unroll
        for (int a = 0; a < 2; ++a)
#pragma unroll
            for (int b = 0; b < 2; ++b)
#pragma unroll
                for (int m = 0; m < 4; ++m)
#pragma unroll
                    for (int n = 0; n < 2; ++n) acc[a][b][m][n] = (f32x4){0.f, 0.f, 0.f, 0.f};
        cur = nxt; cA = nA; cB = nB; ++ui;
        if constexpr (GATHER) {
#pragma unroll
            for (int h = 0; h < 2; ++h)
#pragma unroll
                for (int i = 0; i < 2; ++i) gcur[h][i] = gnx[h][i]; }
    }
    PG8_WAIT_V(0);
    if (wr == 0) PG8_BAR;
    PG8_BAR;
#undef PG8_SA
#undef PG8_SB
#undef PG8_STAGE
#undef PG8_STAGE_A
#undef PG8_LDA
#undef PG8_LDB
#undef PG8_MMA
#undef PG8_WAIT_V
#undef PG8_WAIT_L
#undef PG8_BAR
#undef PG8_SCHED
}
}

struct FEpiU {
    bf16_t* U; int ldu; bf16_t* VT; int odd;
    __device__ __forceinline__ void operator()(const f32x4 (&acc)[2][2][4][2], const pg8::Unit& u, int wr, int wc, int fr, int fq) const {
        const int row0 = u.pm * 256 + wr * 64 + fr, col0 = u.pn * 256 + wc * 32 + 4 * fq;
        const bool vt = odd && col0 >= 2048 && col0 < 3072;
#pragma unroll
        for (int ai = 0; ai < 2; ++ai)
#pragma unroll
            for (int m = 0; m < 4; ++m) {
                const int row = row0 + ai * 128 + m * 16;
                bf16_t* rowp = U + (size_t)row * ldu + col0;
#pragma unroll
                for (int bj = 0; bj < 2; ++bj)
#pragma unroll
                    for (int n = 0; n < 2; ++n) {
                        const f32x4 v = acc[ai][bj][m][n];
                        st_bf16x4(rowp + bj * 128 + n * 16, v);
                        if (vt) {
#pragma unroll
                            for (int i = 0; i < 4; ++i) VT[(size_t)(col0 - 2048 + bj * 128 + n * 16 + i) * NTOK + row] = (bf16_t)(cvt_pk_bf16(v[i], 0.f) & 0xffffu);
                        }
                    }
            }
    }
};
struct FEpiPool {
    bf16_t* AMIX; const float* scale;
    __device__ __forceinline__ void operator()(const f32x4 (&acc)[2][2][4][2], const pg8::Unit& u, int wr, int wc, int fr, int fq) const {
        const int row0 = u.pm * 256 + wr * 64 + fr, col0 = u.pn * 256 + wc * 32 + 4 * fq;
#pragma unroll
        for (int bj = 0; bj < 2; ++bj)
#pragma unroll
            for (int n = 0; n < 2; ++n) {
                const f32x4 sc = *(const f32x4*)(scale + col0 + bj * 128 + n * 16);
#pragma unroll
                for (int ai = 0; ai < 2; ++ai)
#pragma unroll
                    for (int m = 0; m < 4; ++m) st_bf16x4(AMIX + (size_t)(row0 + ai * 128 + m * 16) * D + 1024 + col0 + bj * 128 + n * 16, acc[ai][bj][m][n] * sc);
            }
    }
};
struct FEpiRes {
    float* X; const float* MODl;
    __device__ __forceinline__ void operator()(const f32x4 (&acc)[2][2][4][2], const pg8::Unit& u, int wr, int wc, int fr, int fq) const {
        const int row0 = u.pm * 256 + wr * 64 + fr, col0 = u.pn * 256 + wc * 32 + 4 * fq;
        const int s = u.pm < 32 ? (u.pm >> 3) : 4;
        const float* g = MODl + (size_t)s * MODW + col0;
        f32x4 gv[2][2];
#pragma unroll
        for (int bj = 0; bj < 2; ++bj)
#pragma unroll
            for (int n = 0; n < 2; ++n) gv[bj][n] = *(const f32x4*)(g + bj * 128 + n * 16);
#pragma unroll
        for (int ai = 0; ai < 2; ++ai)
#pragma unroll
            for (int m = 0; m < 4; ++m) {
                float* rowp = X + (size_t)(row0 + ai * 128 + m * 16) * D + col0;
#pragma unroll
                for (int bj = 0; bj < 2; ++bj)
#pragma unroll
                    for (int n = 0; n < 2; ++n) { float* p = rowp + bj * 128 + n * 16; *(f32x4*)p = *(const f32x4*)p + gv[bj][n] * acc[ai][bj][m][n]; }
            }
    }
};

__device__ __forceinline__ void moe_tiles(const Frame& F, int l, LAS int* ts) {
    if (F.tid == 0) { int acc = 0;
        for (int e = 0; e < NEXP; ++e) { const int c = (int)__hip_atomic_load(F.ctl() + CW_CNT + l * 32 + e, __ATOMIC_RELAXED, __HIP_MEMORY_SCOPE_AGENT); ts[e] = acc; ts[33 + e] = c; acc += (c + 255) >> 8; }
        ts[32] = acc; }
    __syncthreads();
}
__device__ __forceinline__ int moe_find(const LAS int* ts, int ti) { int e = 0;
#pragma unroll 1
    for (int q = 1; q < NEXP; ++q) e = (ts[q] <= ti) ? q : e;
    return e; }

__device__ __forceinline__ void moe_up_phase(const Frame& F, int l) {
    LAS int* ts = (LAS int*)(F.lds + 1024);
    moe_tiles(F, l, ts);
    const int T = ts[32], fr = F.lane & 15, fq = F.lane >> 4;
#pragma unroll 1
    for (int u = F.bid; u < T * 8; u += F.G) {
        const int ti = u >> 3, q = (u >> 1) & 3, pn = u & 1;
        const int e = moe_find(ts, ti), j = ti - ts[e], cnt = ts[33 + e];
        const int* sl = F.SLOT() + (size_t)e * SLOT_CAP;
        const bf16_t* ap[4]; int sv[4];
#pragma unroll
        for (int m = 0; m < 4; ++m) { const int li = j * 256 + q * 64 + m * 16 + fr; sv[m] = li < cnt ? sl[li] : -1; const int tok = sv[m] < 0 ? 0 : (sv[m] >> 1); ap[m] = F.H() + (size_t)tok * D + 8 * fq; }
        const bf16_t* Bt = F.W13() + ((size_t)l * NEXP + e) * 512 * D;
        const bf16_t* bp0 = Bt + (size_t)(pn * 256 + F.wave * 16 + fr) * D + 8 * fq;
        const bf16_t* bp1 = bp0 + (size_t)128 * D;
        f32x4 a[4], b[4];
        sgemm_core(ap, bp0, bp1, D, a, b);
#pragma unroll
        for (int m = 0; m < 4; ++m) {
            const float gate = sv[m] < 0 ? 0.f : F.TOKG()[sv[m]];
            f32x4 hv;
#pragma unroll
            for (int i = 0; i < 4; ++i) hv[i] = sv[m] < 0 ? 0.f : siluf_(a[m][i]) * b[m][i] * gate;
            st_bf16x4(F.HID() + (size_t)(ti * 256 + q * 64 + m * 16 + fr) * FF + pn * 128 + F.wave * 16 + 4 * fq, hv);
        }
    }
}
__device__ __forceinline__ void moe_down_phase(const Frame& F, int l) {
    LAS int* ts = (LAS int*)(F.lds + 1024);
    moe_tiles(F, l, ts);
    const int T = ts[32], fr = F.lane & 15, fq = F.lane >> 4;
#pragma unroll 1
    for (int u = F.bid; u < T * 32; u += F.G) {
        const int ti = u >> 5, q = (u >> 3) & 3, pn = u & 7;
        const int e = moe_find(ts, ti), j = ti - ts[e], cnt = ts[33 + e];
        const int* sl = F.SLOT() + (size_t)e * SLOT_CAP;
        const bf16_t* ap[4]; int sv[4];
#pragma unroll
        for (int m = 0; m < 4; ++m) { const int li = j * 256 + q * 64 + m * 16 + fr; sv[m] = li < cnt ? sl[li] : -1; ap[m] = F.HID() + (size_t)(ti * 256 + q * 64 + m * 16 + fr) * FF + 8 * fq; }
        const bf16_t* Bt = F.W2() + ((size_t)l * NEXP + e) * D * FF;
        const bf16_t* bp0 = Bt + (size_t)(pn * 256 + F.wave * 16 + fr) * FF + 8 * fq;
        const bf16_t* bp1 = bp0 + (size_t)128 * FF;
        f32x4 a[4], b[4];
        sgemm_core(ap, bp0, bp1, FF, a, b);
#pragma unroll
        for (int m = 0; m < 4; ++m) if (sv[m] >= 0) {
            bf16_t* y = F.Y2() + (size_t)sv[m] * D + pn * 256 + F.wave * 16 + 4 * fq;
            st_bf16x4(y, a[m]); st_bf16x4(y + 128, b[m]);
        }
    }
}

constexpr int LDS_TS = 131072;
struct MoeSched {
    const LAS int* ts; int T, NPN, G, c;
    const char* Abase; const char* Bbase; size_t b_estride, b_pnstride, a_tstride; const int* SLOT; int lda;
    __device__ __forceinline__ bool next(int i, pg8::Unit& u) const {
        const int idx = i * G + c; if (idx >= T * NPN) return false;
        const int ti = idx / NPN; u.pm = ti; u.pn = idx - ti * NPN; u.aux = moe_find(ts, ti); return true; }
    __device__ __forceinline__ const char* a_ptr(const pg8::Unit& u) const { return Abase + (size_t)u.pm * a_tstride; }
    __device__ __forceinline__ const char* b_ptr(const pg8::Unit& u) const { return Bbase + (size_t)u.aux * b_estride + (size_t)u.pn * b_pnstride; }
    __device__ __forceinline__ void a_gather(const pg8::Unit& u, const int (&R)[2], const int (&C)[2], unsigned (&off)[2][2]) const {
        const int e = u.aux, j = u.pm - ts[e], cnt = ts[33 + e];
        const int* sl = SLOT + (size_t)e * SLOT_CAP + j * 256;
#pragma unroll
        for (int h = 0; h < 2; ++h)
#pragma unroll
            for (int i = 0; i < 2; ++i) { const int li = h * 128 + R[i]; const int tok = (j * 256 + li < cnt) ? (sl[li] >> 1) : 0; off[h][i] = (unsigned)(tok * lda + C[i]) * 2u; }
    }
};
struct FEpiUp {
    bf16_t* HID; const float* SLOTG; const LAS int* ts;
    __device__ __forceinline__ void operator()(const f32x4 (&acc)[2][2][4][2], const pg8::Unit& u, int wr, int wc, int fr, int fq) const {
        const int e = u.aux, j = u.pm - ts[e], cnt = ts[33 + e];
        const float* sg = SLOTG + (size_t)e * SLOT_CAP + j * 256;
#pragma unroll
        for (int ai = 0; ai < 2; ++ai)
#pragma unroll
            for (int m = 0; m < 4; ++m) {
                const int r = ai * 128 + wr * 64 + m * 16 + fr;
                const float gate = (j * 256 + r < cnt) ? sg[r] : 0.f;
                bf16_t* hp = HID + (size_t)(u.pm * 256 + r) * FF + u.pn * 128 + wc * 32 + 4 * fq;
#pragma unroll
                for (int n = 0; n < 2; ++n) { const f32x4 a = acc[ai][0][m][n], b = acc[ai][1][m][n]; f32x4 hv;
#pragma unroll
                    for (int i = 0; i < 4; ++i) hv[i] = siluf_(a[i]) * b[i] * gate;
                    st_bf16x4(hp + n * 16, hv); }
            }
    }
};
struct FEpiDown {
    bf16_t* Y2; const int* SLOT; const LAS int* ts;
    __device__ __forceinline__ void operator()(const f32x4 (&acc)[2][2][4][2], const pg8::Unit& u, int wr, int wc, int fr, int fq) const {
        const int e = u.aux, j = u.pm - ts[e], cnt = ts[33 + e];
        const int* sl = SLOT + (size_t)e * SLOT_CAP + j * 256;
#pragma unroll
        for (int ai = 0; ai < 2; ++ai)
#pragma unroll
            for (int m = 0; m < 4; ++m) {
                const int r = ai * 128 + wr * 64 + m * 16 + fr;
                if (j * 256 + r < cnt) {
                    bf16_t* yp = Y2 + (size_t)sl[r] * D + u.pn * 256 + wc * 32 + 4 * fq;
#pragma unroll
                    for (int bj = 0; bj < 2; ++bj)
#pragma unroll
                        for (int n = 0; n < 2; ++n) st_bf16x4(yp + bj * 128 + n * 16, acc[ai][bj][m][n]);
                }
            }
    }
};
__device__ __forceinline__ void moe_up_fast(const Frame& F, int l) {
    LAS int* ts = (LAS int*)(F.lds + LDS_TS);
    moe_tiles(F, l, ts);
    MoeSched S; S.ts = ts; S.T = ts[32]; S.NPN = 2; S.G = F.G; S.c = F.bid;
    S.Abase = (const char*)F.H(); S.a_tstride = 0; S.Bbase = (const char*)(F.W13() + (size_t)l * NEXP * 512 * D); S.b_estride = (size_t)512 * D * 2; S.b_pnstride = (size_t)256 * D * 2;
    S.SLOT = F.SLOT(); S.lda = D;
    FEpiUp E{F.HID(), F.SLOTG(), ts};
    pg8::gemm_phase<FEpiUp, MoeSched, true>(F.lds, F.tid, D, D, D, S, E);
}
__device__ __forceinline__ void moe_down_fast(const Frame& F, int l) {
    LAS int* ts = (LAS int*)(F.lds + LDS_TS);
    moe_tiles(F, l, ts);
    MoeSched S; S.ts = ts; S.T = ts[32]; S.NPN = 8; S.G = F.G; S.c = F.bid;
    S.Abase = (const char*)F.HID(); S.a_tstride = (size_t)256 * FF * 2; S.Bbase = (const char*)(F.W2() + (size_t)l * NEXP * D * FF); S.b_estride = (size_t)D * FF * 2; S.b_pnstride = (size_t)256 * FF * 2;
    S.SLOT = F.SLOT(); S.lda = FF;
    FEpiDown E{F.Y2(), F.SLOT(), ts};
    pg8::gemm_phase<FEpiDown, MoeSched, false>(F.lds, F.tid, FF, FF, FF, S, E);
}

__global__ void __launch_bounds__(512, 2) hybrid_fwd(Args args) {
    extern __shared__ __attribute__((aligned(16))) unsigned char lds_raw[];
    Frame F;
    F.lds = (LAS unsigned char*)lds_raw;
    F.tid = threadIdx.x; F.lane = F.tid & 63; F.wave = __builtin_amdgcn_readfirstlane(F.tid >> 6);
    F.G = gridDim.x; F.bid = blockIdx.x;
    F.ka = (const CAS Args*)__builtin_amdgcn_kernarg_segment_ptr();

    volatile LAS unsigned* misc = (volatile LAS unsigned*)(F.lds + LDS_MISC);
    if (F.tid < 64) misc[F.tid] = 0u;
    __syncthreads();
    XcdBarrier bar; bar.bar = F.ctl(); bar.x = 0; bar.st = misc; bar.wave = F.wave;
#if MK_N_LAUNCHES == 1
    bar = xcd_barrier_post(F.ctl(), misc);
#endif
    const int lo = F.ka->ph_lo, hi = F.ka->ph_hi;
    int ph = 0;
#if MK_N_LAUNCHES == 1
#define PHASE_BEGIN() ({ const bool run_ = (lo <= ph && ph < hi); if (run_ && ph > lo) xcd_barrier(bar); ++ph; run_; })
#else
#define PHASE_BEGIN() ({ const bool run_ = (lo <= ph && ph < hi); ++ph; run_; })
#endif

    if (PHASE_BEGIN()) { if (ON(0)) { const Frame P = phase_frame(F); p0_convert(P); p0_mod(P); } }
#pragma unroll 1
    for (int l = 0; l < DEPTH; ++l) {
        const bool odd = l & 1, last = (l == DEPTH - 1);
        const int jh = l >> 1;
        if (PHASE_BEGIN()) { if (ON(1)) { const Frame P = phase_frame(F); if (l == 0) norm1_phase<0>(P, l); else norm1_phase<1>(P, l); } }
        if (PHASE_BEGIN()) {
            const Frame P = phase_frame(F);
            const int N = odd ? ODD_IN : EVEN_IN;
            const bf16_t* Bt = odd ? P.ODWIN() + (size_t)jh * ODD_IN * D : P.EVWIN() + (size_t)jh * EVEN_IN * D;
            EpiU E{P.U(), N, P.VT(), odd ? 1 : 0};
            if (ON(2)) { pg8::DenseSched S; S.init(P.H(), D, 0, Bt, D, NTOK, N, P.G, P.bid); FEpiU FE{P.U(), N, P.VT(), odd ? 1 : 0};
                pg8::gemm_phase<FEpiU, pg8::DenseSched, false>(P.lds, P.tid, D, D, D, S, FE); }
        }
        if (!odd) { if (PHASE_BEGIN()) { if (ON(3)) { const Frame P = phase_frame(F); conv_phase(P, jh); } } }
        else {
            if (PHASE_BEGIN()) { if (ON(4)) { const Frame P = phase_frame(F); attn_mix_phase(P, l); } }
            if (PHASE_BEGIN()) if (ON(5)) { const Frame P = phase_frame(F); pg8::DenseSched S; S.init(P.MIX(), 1024, 256, P.POOLW() + (size_t)jh * 1024 * 256, 256, last ? NLAT : NTOK, 1024, P.G, P.bid); FEpiPool FE{P.AMIX(), P.in(18) + (size_t)jh * 1024};
                pg8::gemm_phase<FEpiPool, pg8::DenseSched, false>(P.lds, P.tid, 256, 1024, 256, S, FE); }
        }
        if (PHASE_BEGIN()) {
            const Frame P = phase_frame(F);
            const bf16_t* Bt = odd ? P.ODWOUT() + (size_t)jh * D * D : P.EVWOUT() + (size_t)jh * D * D;
            EpiRes E{P.X(), P.MOD() + (size_t)l * 5 * MODW + 2 * D};
            if (ON(6)) { pg8::DenseSched S; S.init(P.AMIX(), D, 0, Bt, D, last ? NLAT : NTOK, D, P.G, P.bid); FEpiRes FE{P.X(), P.MOD() + (size_t)l * 5 * MODW + 2 * D};
                pg8::gemm_phase<FEpiRes, pg8::DenseSched, false>(P.lds, P.tid, D, D, D, S, FE); }
        }
        if (PHASE_BEGIN()) { if (ON(7)) { const Frame P = phase_frame(F); norm2_router_phase(P, l); } }
        if (PHASE_BEGIN()) { if (ON(8)) { const Frame P = phase_frame(F); moe_up_fast(P, l); } }
        if (PHASE_BEGIN()) { if (ON(9)) { const Frame P = phase_frame(F); moe_down_fast(P, l); } }
    }
    if (PHASE_BEGIN()) { if (ON(10)) { const Frame P = phase_frame(F); norm1_phase<2>(P, DEPTH); } }
#if TRUNC
    if (lo == 99) { const Frame P = phase_frame(F);
        for (size_t i = (size_t)P.bid * 512 + P.tid; i < (size_t)NLAT * D / 4; i += (size_t)P.G * 512) {
#if DUMP_SEL == 0
            ((f32x4*)P.out())[i] = ((const f32x4*)P.X())[i];
#elif DUMP_SEL == 1
            const u32x2 a = ((const u32x2*)P.AMIX())[i]; f32x4 v; v[0] = bf_lo(a.x); v[1] = bf_hi(a.x); v[2] = bf_lo(a.y); v[3] = bf_hi(a.y); ((f32x4*)P.out())[i] = v;
#elif DUMP_SEL == 2
            f32x4 v = {0.f, 0.f, 0.f, 0.f}; if (i < (size_t)1024 * NTOK / 4) { const u32x2 a = ((const u32x2*)P.VT())[i]; v[0] = bf_lo(a.x); v[1] = bf_hi(a.x); v[2] = bf_lo(a.y); v[3] = bf_hi(a.y); } ((f32x4*)P.out())[i] = v;
#else
            f32x4 v = {0.f, 0.f, 0.f, 0.f}; if (i < (size_t)1024 * NTOK / 4) { const u32x2 a = ((const u32x2*)P.MIX())[i]; v[0] = bf_lo(a.x); v[1] = bf_hi(a.x); v[2] = bf_lo(a.y); v[3] = bf_hi(a.y); } ((f32x4*)P.out())[i] = v;
#endif
        } }
#endif
}
constexpr int N_PHASES = 1 + (7 + 8 + 7 + 8) + 1;

extern "C" void kernel_launch(void* const* d_in, const int* in_sizes, int n_in, void* d_out, int out_size, void* d_ws, size_t ws_size, hipStream_t stream) {
    static int grid = 0;
    if (grid == 0) {
        if (n_in != 28 || in_sizes[0] != NLAT * D || out_size != NLAT * D || ws_size < WS_END) {
            fprintf(stderr, "kernel_launch: unexpected shapes (n_in %d, in0 %d, out %d, ws %zu < %zu); nothing launched\n", n_in, n_in > 0 ? in_sizes[0] : -1, out_size, ws_size, (size_t)WS_END); grid = -1; return; }
        int dev = 0, cus = 0, per_cu = 0;
        if (hipGetDevice(&dev) != hipSuccess || hipDeviceGetAttribute(&cus, hipDeviceAttributeMultiprocessorCount, dev) != hipSuccess) { grid = -1; return; }
        if (hipFuncSetAttribute((const void*)hybrid_fwd, hipFuncAttributeMaxDynamicSharedMemorySize, LDS_BYTES) != hipSuccess) { fprintf(stderr, "kernel_launch: hipFuncSetAttribute failed\n"); grid = -1; return; }
        if (hipOccupancyMaxActiveBlocksPerMultiprocessor(&per_cu, (const void*)hybrid_fwd, 512, LDS_BYTES) != hipSuccess || per_cu < 1)
            fprintf(stderr, "kernel_launch: occupancy query reports %d blocks per CU\n", per_cu);
        (void)hipGetLastError();
        grid = cus;
    }
    if (grid < 0) return;
    if (hipMemsetAsync((char*)d_ws + WS_CTL, 0, CTL_BYTES, stream) != hipSuccess) { fprintf(stderr, "kernel_launch: memset failed\n"); return; }
    Args a{};
    for (int i = 0; i < 28; ++i) a.in[i] = (const float*)d_in[i];
    a.out = (float*)d_out; a.ws = (unsigned char*)d_ws;
#if MK_N_LAUNCHES == 1
    a.ph_lo = 0; a.ph_hi = N_PHASES;
    hipLaunchKernelGGL(hybrid_fwd, dim3(grid), dim3(512), LDS_BYTES, stream, a);
#else
#if TRUNC
    for (int p = 0; p < TRUNC; ++p) { a.ph_lo = p; a.ph_hi = p + 1; hipLaunchKernelGGL(hybrid_fwd, dim3(grid), dim3(512), LDS_BYTES, stream, a); }
    a.ph_lo = 99; a.ph_hi = 100; hipLaunchKernelGGL(hybrid_fwd, dim3(grid), dim3(512), LDS_BYTES, stream, a);
#else
    for (int p = 0; p < N_PHASES; ++p) { a.ph_lo = p; a.ph_hi = p + 1; hipLaunchKernelGGL(hybrid_fwd, dim3(grid), dim3(512), LDS_BYTES, stream, a); }
#endif
#endif
    const hipError_t le = hipPeekAtLastError();
    if (le != hipSuccess) fprintf(stderr, "kernel_launch: launch failed: %s\n", hipGetErrorName(le));
}
```

```cpp
#include <hip/hip_runtime.h>
#include <cstdio>
#include <cstdint>

#ifndef TRUNC
#define TRUNC 0
#endif
#ifndef DUMP_SEL
#define DUMP_SEL 2
#endif
#ifndef DBL
#define DBL 0u
#endif
#define REPS(k) (1 + (int)(((DBL) >> (k)) & 1u))
#ifndef PROBE_KA
#define PROBE_KA -1
#define PROBE_KB -1
#endif
#ifndef NORM2_SUB
#define NORM2_SUB -1
#endif
#ifndef PHM
#define PHM 0xffffffffu
#endif
#define ON(k) (((PHM) >> (k)) & 1u)
#ifndef MK_N_LAUNCHES
#define MK_N_LAUNCHES 1
#endif

#define LAS __attribute__((address_space(3)))
typedef unsigned short bf16_t;
typedef short bf16x8 __attribute__((ext_vector_type(8)));
typedef float f32x4 __attribute__((ext_vector_type(4)));
typedef float f32x2 __attribute__((ext_vector_type(2)));
typedef unsigned u32x4 __attribute__((ext_vector_type(4)));
typedef unsigned u32x2 __attribute__((ext_vector_type(2)));

constexpr int D = 2048, NB = 4, SEQ = 2048, CTXL = 256, DEPTH = 4;
constexpr int NLAT = NB * SEQ, NCTX = NB * CTXL, NTOK = NLAT + NCTX;
constexpr int EVEN_IN = 5120, ODD_IN = 4096, MODW = 6 * D;
constexpr int NEXP = 32, FF = 256;
constexpr int UE_LD = 3072;
constexpr int SLOT_CAP = NTOK;
constexpr int HID_ROWS = 26624;

constexpr size_t al256(size_t x) { return (x + 255) & ~(size_t)255; }
constexpr size_t WS_CTL = 0, CTL_BYTES = 65536;
constexpr int CW_CNT = 8192;
constexpr size_t WS_MOD = WS_CTL + CTL_BYTES;
constexpr size_t WS_WRT = al256(WS_MOD + (size_t)DEPTH * 5 * MODW * 4);
constexpr size_t WS_TOKG = al256(WS_WRT + (size_t)DEPTH * (D / 4) * 3 * 64 * 4);
constexpr size_t WS_SLOT = al256(WS_TOKG + (size_t)NTOK * 2 * 4);
constexpr size_t WS_SLOTG = al256(WS_SLOT + (size_t)NEXP * SLOT_CAP * 4);
constexpr size_t WS_X = al256(WS_SLOTG + (size_t)NEXP * SLOT_CAP * 4);
constexpr size_t WS_H = al256(WS_X + (size_t)NTOK * D * 4);
constexpr size_t WS_U = al256(WS_H + (size_t)NTOK * D * 2);
constexpr size_t WS_VT = al256(WS_U + (size_t)NTOK * EVEN_IN * 2);
constexpr size_t WS_AMIX = al256(WS_VT + (size_t)1024 * NTOK * 2);
constexpr size_t WS_MIX = al256(WS_AMIX + (size_t)NTOK * D * 2);
constexpr size_t WS_HID = al256(WS_MIX + (size_t)NTOK * 1024 * 2);
constexpr size_t WS_Y2 = al256(WS_HID + (size_t)HID_ROWS * FF * 2);
constexpr size_t WS_EVWIN = al256(WS_Y2 + (size_t)NTOK * 2 * D * 2);
constexpr size_t WS_EVWOUT = al256(WS_EVWIN + (size_t)2 * EVEN_IN * D * 2);
constexpr size_t WS_ODWIN = al256(WS_EVWOUT + (size_t)2 * D * D * 2);
constexpr size_t WS_ODWOUT = al256(WS_ODWIN + (size_t)2 * ODD_IN * D * 2);
constexpr size_t WS_POOLW = al256(WS_ODWOUT + (size_t)2 * D * D * 2);
constexpr size_t WS_W13 = al256(WS_POOLW + (size_t)2 * 1024 * 256 * 2);
constexpr size_t WS_W2 = al256(WS_W13 + (size_t)DEPTH * NEXP * 512 * D * 2);
constexpr size_t WS_END = al256(WS_W2 + (size_t)DEPTH * NEXP * D * FF * 2);

constexpr int LDS_BYTES = 163840;
constexpr int LDS_MISC = LDS_BYTES - 256;

#define XB_TMO      128
#define XB_XCNT(j)  (256  + 64 * (j))
#define XB_XSUB(j)  (1280 + 64 * (j))
#define XB_XGEN(j)  (2304 + 64 * (j))
#define XB_TOP      3328
#define XB_TOPGEN   3392
#define XCD_BAR_WORDS 3456
#define XB_SPIN_CAP (1u << 18)

__device__ __forceinline__ unsigned xb_ld(unsigned* p)              { return __hip_atomic_load(p, __ATOMIC_RELAXED, __HIP_MEMORY_SCOPE_AGENT); }
__device__ __forceinline__ unsigned xb_add(unsigned* p, unsigned v) { return __hip_atomic_fetch_add(p, v, __ATOMIC_RELAXED, __HIP_MEMORY_SCOPE_AGENT); }
__device__ __forceinline__ unsigned xb_xcc_id() { return (unsigned)__builtin_amdgcn_s_getreg((3 << 11) | 20) & 0xFu; }
#define XB_SPIN(cond, bar) do { unsigned _sp = 0; while (cond) { __builtin_amdgcn_s_sleep(1); \
    if ((++_sp & 255u) == 0u) { if (xb_ld(&(bar)[XB_TMO])) break; if (_sp > XB_SPIN_CAP) { atomicAdd(&(bar)[XB_TMO], 1u); break; } } } } while (0)

struct XcdBarrier { unsigned* bar; unsigned x; volatile LAS unsigned* st; int wave; };
__device__ __forceinline__ bool xb_thread0(int wave) { int z = 0, w = wave; asm volatile("" : "+s"(z), "+s"(w)); return w == 0 && __builtin_amdgcn_mbcnt_hi(~0u, __builtin_amdgcn_mbcnt_lo(~0u, (unsigned)z)) == 0u; }

__device__ __forceinline__ XcdBarrier xcd_barrier_post(unsigned* bar, volatile LAS unsigned* st) {
    XcdBarrier b; b.bar = bar; b.x = xb_xcc_id(); b.st = st;
    b.wave = __builtin_amdgcn_readfirstlane((int)(threadIdx.x >> 6));
    if (threadIdx.x == 0) (void)xb_add(&bar[XB_XCNT(b.x)], 1u);
    return b;
}
__device__ __forceinline__ void xcd_barrier_complete(unsigned* bar, unsigned x, unsigned& nloc, unsigned& nx) {
    const unsigned G = gridDim.x * gridDim.y * gridDim.z;
    unsigned sum, cnt, mine, sp = 0u;
    for (;;) {
        sum = 0u; cnt = 0u; mine = 0u;
#pragma unroll
        for (unsigned j = 0; j < 16; ++j) { const unsigned c = xb_ld(&bar[XB_XCNT(j)]); sum += c; cnt += (c > 0u) ? 1u : 0u; mine = (j == x) ? c : mine; }
        if (sum == G) break;
        __builtin_amdgcn_s_sleep(1);
        if ((++sp & 255u) == 0u) { if (xb_ld(&bar[XB_TMO])) break; if (sp > XB_SPIN_CAP) { atomicAdd(&bar[XB_TMO], 1u); break; } }
    }
    nloc = mine > 0u ? mine : 1u; nx = cnt > 0u ? cnt : 1u;
}
__device__ __forceinline__ void xcd_barrier(const XcdBarrier& b) {
    asm volatile("s_waitcnt vmcnt(0)" ::: "memory");
    __syncthreads();
    if (xb_thread0(b.wave)) {
        unsigned* bar = b.bar;
        __builtin_amdgcn_s_waitcnt(0);
        unsigned nloc = b.st[0], nx = b.st[1];
        if (nloc == 0u) { xcd_barrier_complete(bar, xb_xcc_id(), nloc, nx); b.st[0] = nloc; b.st[1] = nx; }
        const unsigned old = xb_add(&bar[XB_XSUB(b.x)], 1u);
        const unsigned gen = old / nloc;
        if (old + 1u == (gen + 1u) * nloc) {
            __builtin_amdgcn_fence(__ATOMIC_RELEASE, "agent");
            asm volatile("s_waitcnt vmcnt(0)" ::: "memory");
            const unsigned og = xb_add(&bar[XB_TOP], 1u);
            const unsigned tg = og / nx;
            if (og + 1u == (tg + 1u) * nx) xb_add(&bar[XB_TOPGEN], 1u);
            else XB_SPIN(xb_ld(&bar[XB_TOPGEN]) == tg, bar);
            __builtin_amdgcn_fence(__ATOMIC_ACQUIRE, "agent");
            xb_add(&bar[XB_XGEN(b.x)], 1u);
            asm volatile("s_waitcnt vmcnt(0)" ::: "memory");
        } else {
            XB_SPIN(xb_ld(&bar[XB_XGEN(b.x)]) == gen, bar);
            __builtin_amdgcn_fence(__ATOMIC_ACQUIRE, "agent");
            asm volatile("s_waitcnt vmcnt(0)" ::: "memory");
        }
    }
    __syncthreads();
}

typedef __bf16 bf16v2_t __attribute__((ext_vector_type(2)));
__device__ __forceinline__ unsigned cvt_pk_bf16(float lo, float hi) { const f32x2 v = {lo, hi}; const bf16v2_t r = __builtin_convertvector(v, bf16v2_t); return __builtin_bit_cast(unsigned, r); }
__device__ __forceinline__ float bf_lo(unsigned u) { return __uint_as_float(u << 16); }
__device__ __forceinline__ float bf_hi(unsigned u) { return __uint_as_float(u & 0xffff0000u); }
__device__ __forceinline__ float shfl_x(float v, int o, int lane) { return __builtin_bit_cast(float, __builtin_amdgcn_ds_bpermute((lane ^ o) << 2, __builtin_bit_cast(int, v))); }
template <int CTRL> __device__ __forceinline__ float dpp_f(float v) { return __builtin_bit_cast(float, __builtin_amdgcn_update_dpp(0, __builtin_bit_cast(int, v), CTRL, 0xF, 0xF, true)); }
__device__ __forceinline__ float wave_sum(float v, int) {
    v += dpp_f<0xB1>(v); v += dpp_f<0x4E>(v); v += dpp_f<0x141>(v); v += dpp_f<0x140>(v);
    const int iv = __builtin_bit_cast(int, v);
    return (__builtin_bit_cast(float, __builtin_amdgcn_readlane(iv, 0)) + __builtin_bit_cast(float, __builtin_amdgcn_readlane(iv, 16))) +
           (__builtin_bit_cast(float, __builtin_amdgcn_readlane(iv, 32)) + __builtin_bit_cast(float, __builtin_amdgcn_readlane(iv, 48)));
}
__device__ __forceinline__ float sigmoidf_(float x) { return __builtin_amdgcn_rcpf(1.0f + __builtin_amdgcn_exp2f(-1.4426950408889634f * x)); }
__device__ __forceinline__ float siluf_(float x) { return x * __builtin_amdgcn_rcpf(1.0f + __builtin_amdgcn_exp2f(-1.4426950408889634f * x)); }

struct Args { const float* in[28]; float* out; unsigned char* ws; int ph_lo, ph_hi; };
#define CAS __attribute__((address_space(4)))
struct Frame {
    LAS unsigned char* lds; int tid, lane, wave; int G, bid;
    const CAS Args* ka;
    __device__ __forceinline__ const float* in(int i) const { return ka->in[i]; }
    __device__ __forceinline__ unsigned char* ws() const { return ka->ws; }
    __device__ __forceinline__ float* out() const { return ka->out; }
    __device__ __forceinline__ unsigned* ctl() const { return (unsigned*)(ws() + WS_CTL); }
    __device__ __forceinline__ float* MOD() const { return (float*)(ws() + WS_MOD); }
    __device__ __forceinline__ float* WRT() const { return (float*)(ws() + WS_WRT); }
    __device__ __forceinline__ float* TOKG() const { return (float*)(ws() + WS_TOKG); }
    __device__ __forceinline__ int* SLOT() const { return (int*)(ws() + WS_SLOT); }
    __device__ __forceinline__ float* SLOTG() const { return (float*)(ws() + WS_SLOTG); }
    __device__ __forceinline__ float* X() const { return (float*)(ws() + WS_X); }
    __device__ __forceinline__ bf16_t* H() const { return (bf16_t*)(ws() + WS_H); }
    __device__ __forceinline__ bf16_t* U() const { return (bf16_t*)(ws() + WS_U); }
    __device__ __forceinline__ bf16_t* VT() const { return (bf16_t*)(ws() + WS_VT); }
    __device__ __forceinline__ bf16_t* AMIX() const { return (bf16_t*)(ws() + WS_AMIX); }
    __device__ __forceinline__ bf16_t* MIX() const { return (bf16_t*)(ws() + WS_MIX); }
    __device__ __forceinline__ bf16_t* HID() const { return (bf16_t*)(ws() + WS_HID); }
    __device__ __forceinline__ bf16_t* Y2() const { return (bf16_t*)(ws() + WS_Y2); }
    __device__ __forceinline__ bf16_t* EVWIN() const { return (bf16_t*)(ws() + WS_EVWIN); }
    __device__ __forceinline__ bf16_t* EVWOUT() const { return (bf16_t*)(ws() + WS_EVWOUT); }
    __device__ __forceinline__ bf16_t* ODWIN() const { return (bf16_t*)(ws() + WS_ODWIN); }
    __device__ __forceinline__ bf16_t* ODWOUT() const { return (bf16_t*)(ws() + WS_ODWOUT); }
    __device__ __forceinline__ bf16_t* POOLW() const { return (bf16_t*)(ws() + WS_POOLW); }
    __device__ __forceinline__ bf16_t* W13() const { return (bf16_t*)(ws() + WS_W13); }
    __device__ __forceinline__ bf16_t* W2() const { return (bf16_t*)(ws() + WS_W2); }
};

__device__ __forceinline__ Frame phase_frame(const Frame& F0) {
    Frame F = F0;
    int z = 0; asm volatile("" : "+s"(z));
    const int lane = (int)__builtin_amdgcn_mbcnt_hi(~0u, __builtin_amdgcn_mbcnt_lo(~0u, (unsigned)z));
    int w = F0.wave; asm volatile("" : "+s"(w));
    F.lane = lane; F.wave = w; F.tid = w * 64 + lane;
    unsigned long long k = (unsigned long long)F0.ka; asm volatile("" : "+s"(k)); F.ka = (const CAS Args*)k;
    int b = F0.bid; asm volatile("" : "+s"(b)); F.bid = b;
    return F;
}

struct CvtTile { const float* src; bf16_t* dst; int N, K; };
__device__ __forceinline__ int cvt_layer_tiles(int L) { return (L & 1) ? (32 * 32 + 32 * 16 + 4 * 4 * 2 + 3 * 32 * 32 * 2) : (32 * 40 + 32 * 16 + 3 * 32 * 32 * 2); }
__device__ __forceinline__ void cvt_desc(const Frame& F, int L, int t, CvtTile& d) {
    const int j = L >> 1, odd = L & 1;
    const int A0 = odd ? 32 * 32 : 32 * 40, A1 = A0 + 32 * 16, A2 = A1 + (odd ? 32 : 0), A3 = A2 + 2048, A4 = A3 + 2048;
    const float* src; bf16_t* dst; int K, N, ro = 0, w13 = 0, evin = 0; size_t dstb = 0; int r;
    if (t < A0)      { r = t;      evin = !odd; K = D; N = odd ? ODD_IN : EVEN_IN; src = (odd ? F.in(15) : F.in(8)) + (size_t)j * K * N; dst = (odd ? F.ODWIN() : F.EVWIN()) + (size_t)j * N * K; }
    else if (t < A1) { r = t - A0; K = D; N = D; src = (odd ? F.in(19) : F.in(14)) + (size_t)j * K * N; dst = (odd ? F.ODWOUT() : F.EVWOUT()) + (size_t)j * N * K; }
    else if (t < A2) { r = t - A1; K = 256; N = 256; src = F.in(17) + (size_t)j * 4 * 256 * 256; dst = F.POOLW() + (size_t)j * 1024 * 256; dstb = (size_t)256 * 256; }
    else if (t < A3) { r = t - A2; K = D; N = FF; src = F.in(24) + (size_t)L * NEXP * D * FF; dst = F.W13() + (size_t)L * NEXP * 512 * D; dstb = (size_t)512 * D; w13 = 1; }
    else if (t < A4) { r = t - A3; K = D; N = FF; src = F.in(25) + (size_t)L * NEXP * D * FF; dst = F.W13() + (size_t)L * NEXP * 512 * D; dstb = (size_t)512 * D; w13 = 1; ro = 128; }
    else             { r = t - A4; K = FF; N = D; src = F.in(26) + (size_t)L * NEXP * FF * D; dst = F.W2() + (size_t)L * NEXP * D * FF; dstb = (size_t)D * FF; }
    const int tk = K / 64, tn = N / 128, per = tk * tn, b = r / per, rem = r - b * per, k0 = (rem / tn) * 64, n0 = (rem % tn) * 128;
    int drow = w13 ? (n0 / 128) * 256 + ro : n0;
    if (evin && n0 >= 1024) { const int grp = n0 >> 10, kq = (n0 & 1023) >> 7;
        drow = (grp <= 2 ? 1024 : 3072) + 256 * kq + ((grp == 2 || grp == 4) ? 128 : 0); }
    d.src = src + (size_t)b * K * N + (size_t)k0 * N + n0; d.dst = dst + (size_t)b * dstb + (size_t)drow * K + k0; d.N = N; d.K = K;
}
constexpr int CVT_SPLIT = 3456, CVT_E1 = 864, CVT_E2 = 864 + 1536;
__device__ __forceinline__ void convert_layer(const Frame& F, int L, int first, int stride, int t_lo = 0, int t_hi = 1 << 30) {
    constexpr int LD = 129;
    LAS float* T = (LAS float*)F.lds;
    const int tid = F.tid, ntile = cvt_layer_tiles(L) < t_hi ? cvt_layer_tiles(L) : t_hi;
    const int lk = tid >> 5, lc = (tid & 31) * 4;
    const int sn = tid >> 2, sk = (tid & 3) * 16;
    f32x4 v[2][4]; CvtTile d[2];
    int t = t_lo + first;
#pragma unroll
    for (int q = 0; q < 2; ++q) { const int tq = t + q * stride; d[q].src = nullptr; d[q].dst = nullptr; d[q].N = 0; d[q].K = 0;
        if (tq < ntile) { cvt_desc(F, L, tq, d[q]);
#pragma unroll
            for (int p = 0; p < 4; ++p) v[q][p] = __builtin_nontemporal_load((const f32x4*)(d[q].src + (size_t)(lk + 16 * p) * d[q].N + lc)); } }
#pragma unroll 1
    for (; t < ntile; t += 2 * stride) {
#pragma unroll
        for (int q = 0; q < 2; ++q) {
            const int tq = t + q * stride;
            if (tq < ntile) {
                LAS float* Tb = T + q * (64 * LD);
#pragma unroll
                for (int p = 0; p < 4; ++p) { LAS float* w = Tb + (lk + 16 * p) * LD + lc; w[0] = v[q][p][0]; w[1] = v[q][p][1]; w[2] = v[q][p][2]; w[3] = v[q][p][3]; }
                __syncthreads();
                bf16_t* dp = d[q].dst + (size_t)sn * d[q].K + sk;
                const int tn = tq + 2 * stride;
                if (tn < ntile) { cvt_desc(F, L, tn, d[q]);
#pragma unroll
                    for (int p = 0; p < 4; ++p) v[q][p] = __builtin_nontemporal_load((const f32x4*)(d[q].src + (size_t)(lk + 16 * p) * d[q].N + lc)); }
                float x[16];
#pragma unroll
                for (int e = 0; e < 16; ++e) x[e] = Tb[(sk + e) * LD + sn];
                u32x4 w0, w1;
                w0.x = cvt_pk_bf16(x[0], x[1]); w0.y = cvt_pk_bf16(x[2], x[3]); w0.z = cvt_pk_bf16(x[4], x[5]); w0.w = cvt_pk_bf16(x[6], x[7]);
                w1.x = cvt_pk_bf16(x[8], x[9]); w1.y = cvt_pk_bf16(x[10], x[11]); w1.z = cvt_pk_bf16(x[12], x[13]); w1.w = cvt_pk_bf16(x[14], x[15]);
                *(u32x4*)dp = w0; *(u32x4*)(dp + 8) = w1;
            }
        }
    }
    __syncthreads();
}
struct CvtPlan { int i_hi, c_hi, n_lo, u_lo, nt; };
__device__ __forceinline__ CvtPlan cvt_plan(int Lprev, int G) {
    CvtPlan p; p.nt = cvt_layer_tiles(Lprev + 1);
    if (G != 256) { p.i_hi = 0; p.c_hi = 0; p.n_lo = p.nt; p.u_lo = p.nt; return p; }
    if (Lprev & 1) { p.i_hi = CVT_SPLIT; p.c_hi = CVT_SPLIT; } else { p.i_hi = CVT_E1; p.c_hi = CVT_E2; }
    p.u_lo = p.nt - 2032; p.n_lo = p.u_lo - 960; return p;
}
__device__ __forceinline__ void p0_convert(const Frame& F) {
    convert_layer(F, 0, F.bid, F.G);
    const int tid = F.tid;
    for (int i = F.bid * 512 + tid; i < DEPTH * 64 * 3 * 64; i += F.G * 512) {
        const int ln = i & 63, nt = (i >> 6) % 3, s = (i / 192) & 63, l = i / (192 * 64);
        const int c = 16 * nt + (ln & 15), k0 = 32 * s + 8 * (ln >> 4);
        float wv[8];
#pragma unroll
        for (int e = 0; e < 8; ++e) wv[e] = (c < 4) ? F.in(20)[((size_t)l * D + k0 + e) * 4 + c] : (c < 36 ? F.in(22)[((size_t)l * D + k0 + e) * 32 + (c - 4)] : 0.f);
        u32x4 hi, lo;
#pragma unroll
        for (int q = 0; q < 4; ++q) {
            const unsigned hp = cvt_pk_bf16(wv[2 * q], wv[2 * q + 1]);
            const unsigned lp = cvt_pk_bf16(wv[2 * q] - bf_lo(hp), wv[2 * q + 1] - bf_hi(hp));
            hi[q] = hp; lo[q] = lp;
        }
        u32x4* dst = (u32x4*)F.WRT() + ((size_t)(l * 64 + s) * 3 + nt) * 128 + ln;
        dst[0] = hi; dst[64] = lo;
    }
}

__device__ __forceinline__ void mod_layer(const Frame& F, int L, int first, int stride) {
    LAS float* sc = (LAS float*)F.lds;
    LAS float* red = sc + 5 * D;
    for (int i = F.tid; i < 5 * D; i += 512) { const float c = (i < 4 * D) ? F.in(1)[i] : F.in(3)[i - 4 * D]; sc[i] = siluf_(c); }
    __syncthreads();
    const int kq = F.lane >> 4, c4 = (F.lane & 15) * 4;
#pragma unroll 1
    for (int u = first; u < 192; u += stride) {
        const int l = L, n0 = u * 64;
        const float* W = F.in(4) + (size_t)l * D * MODW + n0 + c4;
        f32x4 acc[5];
#pragma unroll
        for (int s = 0; s < 5; ++s) acc[s] = (f32x4){0.f, 0.f, 0.f, 0.f};
#pragma unroll 8
        for (int it = 0; it < 64; ++it) {
            const int k = it * 32 + F.wave * 4 + kq;
            const f32x4 w = *(const f32x4*)(W + (size_t)k * MODW);
#pragma unroll
            for (int s = 0; s < 5; ++s) acc[s] += sc[s * D + k] * w;
        }
#pragma unroll
        for (int s = 0; s < 5; ++s)
#pragma unroll
            for (int i = 0; i < 4; ++i) { float v = acc[s][i]; v += shfl_x(v, 16, F.lane); v += shfl_x(v, 32, F.lane); acc[s][i] = v; }
        if (kq == 0) {
#pragma unroll
            for (int s = 0; s < 5; ++s)
#pragma unroll
                for (int i = 0; i < 4; ++i) red[(F.wave * 5 + s) * 64 + c4 + i] = acc[s][i];
        }
        __syncthreads();
        if (F.tid < 320) { const int s = F.tid >> 6, col = F.tid & 63; float v = F.in(5)[(size_t)l * MODW + n0 + col];
#pragma unroll
            for (int w = 0; w < 8; ++w) v += red[(w * 5 + s) * 64 + col];
            F.MOD()[((size_t)l * 5 + s) * MODW + n0 + col] = v; }
        __syncthreads();
    }
}

template <int MODE>
__device__ __forceinline__ void norm1_phase(const Frame& F, int l) {
    const int nrows = (MODE == 2) ? NLAT : NTOK;
    const float* g = (MODE == 2) ? F.in(27) : F.in(6) + (size_t)l * D;
#pragma unroll 1
    for (int r = F.bid * 8 + F.wave; r < nrows; r += F.G * 8) {
        const int s = r < NLAT ? r / SEQ : 4;
        f32x4 v[8];
        if (MODE == 0) {
            const float* src = r < NLAT ? F.in(0) + (size_t)r * D : F.in(2) + (size_t)(r - NLAT) * D;
#pragma unroll
            for (int j = 0; j < 8; ++j) v[j] = *(const f32x4*)(src + j * 256 + F.lane * 4);
        } else {
            const float* xr = F.X() + (size_t)r * D;
            const float* g5 = F.MOD() + ((size_t)(l - 1) * 5 + s) * MODW + 5 * D;
            const bf16_t* y = F.Y2() + (size_t)r * 2 * D;
#pragma unroll
            for (int j = 0; j < 8; ++j) {
                const int idx = j * 256 + F.lane * 4;
                const f32x4 x = *(const f32x4*)(xr + idx), gg = *(const f32x4*)(g5 + idx);
                const u32x2 a = *(const u32x2*)(y + idx), b = *(const u32x2*)(y + D + idx);
                f32x4 ys; ys[0] = bf_lo(a.x) + bf_lo(b.x); ys[1] = bf_hi(a.x) + bf_hi(b.x); ys[2] = bf_lo(a.y) + bf_lo(b.y); ys[3] = bf_hi(a.y) + bf_hi(b.y);
                v[j] = x + gg * ys;
            }
        }
        float ss = 0.f;
#pragma unroll
        for (int j = 0; j < 8; ++j) ss += v[j][0] * v[j][0] + v[j][1] * v[j][1] + v[j][2] * v[j][2] + v[j][3] * v[j][3];
        ss = wave_sum(ss, F.lane);
        const float rstd = rsqrtf(ss * (1.0f / D) + 1e-6f);
        if (MODE == 2) {
            float* o = F.out() + (size_t)r * D;
#pragma unroll
            for (int j = 0; j < 8; ++j) { const int idx = j * 256 + F.lane * 4; *(f32x4*)(o + idx) = v[j] * rstd * *(const f32x4*)(g + idx); }
        } else {
            float* xr = F.X() + (size_t)r * D;
            const float* sh = F.MOD() + ((size_t)l * 5 + s) * MODW;
            const float* scl = sh + D;
            bf16_t* h = F.H() + (size_t)r * D;
#pragma unroll
            for (int j = 0; j < 8; ++j) {
                const int idx = j * 256 + F.lane * 4;
                *(f32x4*)(xr + idx) = v[j];
                const f32x4 hv = v[j] * rstd * *(const f32x4*)(g + idx) * (1.0f + *(const f32x4*)(scl + idx)) + *(const f32x4*)(sh + idx);
                u32x2 w; w.x = cvt_pk_bf16(hv[0], hv[1]); w.y = cvt_pk_bf16(hv[2], hv[3]);
                *(u32x2*)(h + idx) = w;
            }
        }
    }
}

__device__ __forceinline__ void norm2_router_phase(const Frame& F, int l, bool dry = false) {
    constexpr int RSB = 2056;
    const int nrows = (l == DEPTH - 1) ? NLAT : NTOK;
    LAS bf16_t* hh = (LAS bf16_t*)F.lds;
    LAS bf16_t* hl = hh + 16 * RSB;
    LAS float* part = (LAS float*)(F.lds + 2 * 16 * RSB * 2);
    const float* g2 = F.in(7) + (size_t)l * D;
    const u32x4* wb = (const u32x4*)F.WRT() + (size_t)l * 64 * 3 * 128;
    unsigned* cnt = F.ctl() + CW_CNT + l * 32;
    const int w = F.wave, lane = F.lane;
    LAS int* selp = (LAS int*)(part + 8 * 768 + 16 * 40);
    int nstep = 0;
#pragma unroll 1
    for (int it = F.bid; it < nrows / 16; it += F.G) {
        const int r0 = it * 16;
        const int s = r0 < NLAT ? r0 / SEQ : 4;
        const float* sh = F.MOD() + ((size_t)l * 5 + s) * MODW + 3 * D;
        const float* scl = sh + D;
        {
            f32x4 v[2][8]; float ss[2];
#pragma unroll
            for (int rr = 0; rr < 2; ++rr) { const float* xr = F.X() + (size_t)(r0 + 2 * w + rr) * D;
#pragma unroll
                for (int j = 0; j < 8; ++j) v[rr][j] = *(const f32x4*)(xr + j * 256 + lane * 4); }
#pragma unroll
            for (int rr = 0; rr < 2; ++rr) { float a = 0.f;
#pragma unroll
                for (int j = 0; j < 8; ++j) a += v[rr][j][0] * v[rr][j][0] + v[rr][j][1] * v[rr][j][1] + v[rr][j][2] * v[rr][j][2] + v[rr][j][3] * v[rr][j][3];
                ss[rr] = rsqrtf(wave_sum(a, lane) * (1.0f / D) + 1e-6f); }
#pragma unroll
            for (int j = 0; j < 8; ++j) {
                const int idx = j * 256 + lane * 4;
                const f32x4 gs = *(const f32x4*)(g2 + idx) * (1.0f + *(const f32x4*)(scl + idx)), shv = *(const f32x4*)(sh + idx);
#pragma unroll
                for (int rr = 0; rr < 2; ++rr) {
                    const int lr = 2 * w + rr;
                    const f32x4 hv = v[rr][j] * ss[rr] * gs + shv;
                    u32x2 ph, pl; ph.x = cvt_pk_bf16(hv[0], hv[1]); ph.y = cvt_pk_bf16(hv[2], hv[3]);
                    pl.x = cvt_pk_bf16(hv[0] - bf_lo(ph.x), hv[1] - bf_hi(ph.x)); pl.y = cvt_pk_bf16(hv[2] - bf_lo(ph.y), hv[3] - bf_hi(ph.y));
                    *(u32x2*)(F.H() + (size_t)(r0 + lr) * D + idx) = ph;
                    *(LAS u32x2*)(hh + lr * RSB + idx) = ph; *(LAS u32x2*)(hl + lr * RSB + idx) = pl;
                }
            }
        }
        __syncthreads();
        f32x4 acc[3];
#pragma unroll
        for (int nt = 0; nt < 3; ++nt) acc[nt] = (f32x4){0.f, 0.f, 0.f, 0.f};
        {
            const LAS bf16_t* ah = hh + (lane & 15) * RSB + 256 * w + 8 * (lane >> 4);
            const LAS bf16_t* al = hl + (lane & 15) * RSB + 256 * w + 8 * (lane >> 4);
            const u32x4* bp = wb + (size_t)(8 * w) * 3 * 128 + lane;
            u32x4 wq[2][3][2];
#pragma unroll
            for (int st = 0; st < 2; ++st)
#pragma unroll
                for (int nt = 0; nt < 3; ++nt) { wq[st][nt][0] = bp[(size_t)(st * 3 + nt) * 128]; wq[st][nt][1] = bp[(size_t)(st * 3 + nt) * 128 + 64]; }
#pragma unroll
            for (int ks = 0; ks < 8; ++ks) {
                const bf16x8 xh = *(const LAS bf16x8*)(ah + 32 * ks), xl = *(const LAS bf16x8*)(al + 32 * ks);
#pragma unroll
                for (int nt = 0; nt < 3; ++nt) {
                    const bf16x8 wh = __builtin_bit_cast(bf16x8, wq[ks % 2][nt][0]), wl = __builtin_bit_cast(bf16x8, wq[ks % 2][nt][1]);
                    if (ks + 2 < 8) { wq[ks % 2][nt][0] = bp[(size_t)((ks + 2) * 3 + nt) * 128]; wq[ks % 2][nt][1] = bp[(size_t)((ks + 2) * 3 + nt) * 128 + 64]; }
                    acc[nt] = __builtin_amdgcn_mfma_f32_16x16x32_bf16(wh, xh, acc[nt], 0, 0, 0);
                    acc[nt] = __builtin_amdgcn_mfma_f32_16x16x32_bf16(wl, xh, acc[nt], 0, 0, 0);
                    acc[nt] = __builtin_amdgcn_mfma_f32_16x16x32_bf16(wh, xl, acc[nt], 0, 0, 0);
                }
            }
        }
#pragma unroll
        for (int nt = 0; nt < 3; ++nt) *(LAS f32x4*)(part + (w * 16 + (lane & 15)) * 48 + nt * 16 + 4 * (lane >> 4)) = acc[nt];
        __syncthreads();
        LAS float* lgt = part + 8 * 768;
        { const int rr = F.tid >> 5, cc = F.tid & 31; float a0 = 0.f, a1 = 0.f;
#pragma unroll
          for (int ww = 0; ww < 8; ++ww) { a0 += part[ww * 768 + rr * 48 + cc]; if (cc < 4) a1 += part[ww * 768 + rr * 48 + 32 + cc]; }
          lgt[rr * 40 + cc] = a0; if (cc < 4) lgt[rr * 40 + 32 + cc] = a1; }
        __syncthreads();
        if (F.tid < 16 && !dry) {
            const int r = r0 + F.tid;
            const LAS float* L = lgt + F.tid * 40;
            float gl[4]; float gm = -3.0e38f; int gi = 0;
#pragma unroll
            for (int q = 0; q < 4; ++q) { const float sacc = F.in(21)[l * 4 + q] + L[q]; gl[q] = sacc; if (sacc > gm) { gm = sacc; gi = q; } }
            float gs = 0.f;
#pragma unroll
            for (int q = 0; q < 4; ++q) gs += __expf(gl[q] - gm);
            const float gp = 1.0f / gs;
            float el[8]; float m1 = -3.0e38f; int i1 = 0;
#pragma unroll
            for (int q = 0; q < 8; ++q) { const float sacc = F.in(23)[l * 32 + gi * 8 + q] + L[4 + gi * 8 + q]; el[q] = sacc; if (sacc > m1) { m1 = sacc; i1 = q; } }
            float m2 = -3.0e38f; int i2 = 0;
#pragma unroll
            for (int q = 0; q < 8; ++q) { if (q != i1 && el[q] > m2) { m2 = el[q]; i2 = q; } }
            const float e2 = __expf(m2 - m1);
            const float w1 = gp / (1.0f + e2), w2 = gp * e2 / (1.0f + e2);
            const int ex1 = gi * 8 + i1, ex2 = gi * 8 + i2;
            (void)r;
            LAS int* sp = selp + (nstep * 16 + F.tid) * 4;
            sp[0] = ex1; sp[1] = ex2; sp[2] = __float_as_int(w1); sp[3] = __float_as_int(w2);
        }
        ++nstep;
        __syncthreads();
    }
    if (!dry) {
        const int nsel = nstep * 16;
        LAS int* hist = selp + nsel * 4; LAS int* base = hist + 32;
        if (F.tid < 32) hist[F.tid] = 0;
        __syncthreads();
        int rk1 = 0, rk2 = 0, e1 = 0, e2 = 0;
        if (F.tid < nsel) { e1 = selp[F.tid * 4]; e2 = selp[F.tid * 4 + 1]; rk1 = __hip_atomic_fetch_add(hist + e1, 1, __ATOMIC_RELAXED, __HIP_MEMORY_SCOPE_WORKGROUP); rk2 = __hip_atomic_fetch_add(hist + e2, 1, __ATOMIC_RELAXED, __HIP_MEMORY_SCOPE_WORKGROUP); }
        __syncthreads();
        if (F.tid < 32) { const int c = hist[F.tid]; base[F.tid] = c > 0 ? (int)atomicAdd(cnt + F.tid, (unsigned)c) : 0; }
        __syncthreads();
        if (F.tid < nsel) {
            const int r = (F.bid + (F.tid >> 4) * F.G) * 16 + (F.tid & 15);
            const int p1 = base[e1] + rk1, p2 = base[e2] + rk2;
            F.SLOT()[(size_t)e1 * SLOT_CAP + p1] = r * 2; F.SLOT()[(size_t)e2 * SLOT_CAP + p2] = r * 2 + 1;
            F.SLOTG()[(size_t)e1 * SLOT_CAP + p1] = __int_as_float(selp[F.tid * 4 + 2]); F.SLOTG()[(size_t)e2 * SLOT_CAP + p2] = __int_as_float(selp[F.tid * 4 + 3]);
        }
        __syncthreads();
    }
}

__device__ __forceinline__ void sgemm_core(const bf16_t* (&ap)[4], const bf16_t* bp0, const bf16_t* bp1, int K, f32x4 (&a)[4], f32x4 (&b)[4]) {
#pragma unroll
    for (int m = 0; m < 4; ++m) { a[m] = (f32x4){0.f, 0.f, 0.f, 0.f}; b[m] = (f32x4){0.f, 0.f, 0.f, 0.f}; }
#pragma unroll 2
    for (int k0 = 0; k0 < K; k0 += 32) {
        const bf16x8 b0 = *(const bf16x8*)(bp0 + k0), b1 = *(const bf16x8*)(bp1 + k0);
        bf16x8 af[4];
#pragma unroll
        for (int m = 0; m < 4; ++m) af[m] = *(const bf16x8*)(ap[m] + k0);
#pragma unroll
        for (int m = 0; m < 4; ++m) { a[m] = __builtin_amdgcn_mfma_f32_16x16x32_bf16(b0, af[m], a[m], 0, 0, 0); b[m] = __builtin_amdgcn_mfma_f32_16x16x32_bf16(b1, af[m], b[m], 0, 0, 0); }
    }
}

template <class Epi>
__device__ __forceinline__ void sgemm_phase(const Frame& F, const bf16_t* A, int lda, int a_pn_off, const bf16_t* Bt, int ldb, int M, int N, int K, const Epi& E) {
    const int fr = F.lane & 15, fq = F.lane >> 4;
    const int nM = M / 64, nN = N / 256, total = nM * nN;
#pragma unroll 1
    for (int u = F.bid; u < total; u += F.G) {
        const int pm = u / nN, pn = u % nN;
        const bf16_t* ap[4];
#pragma unroll
        for (int m = 0; m < 4; ++m) ap[m] = A + (size_t)(pm * 64 + m * 16 + fr) * lda + pn * a_pn_off + 8 * fq;
        const bf16_t* bp0 = Bt + (size_t)(pn * 256 + F.wave * 16 + fr) * ldb + 8 * fq;
        const bf16_t* bp1 = bp0 + (size_t)128 * ldb;
        f32x4 a[4], b[4];
        sgemm_core(ap, bp0, bp1, K, a, b);
#pragma unroll
        for (int m = 0; m < 4; ++m) E(pm * 64 + m * 16 + fr, pn * 256 + F.wave * 16 + 4 * fq, a[m], b[m]);
    }
}

__device__ __forceinline__ void st_bf16x4(bf16_t* p, f32x4 v) { u32x2 w; w.x = cvt_pk_bf16(v[0], v[1]); w.y = cvt_pk_bf16(v[2], v[3]); *(u32x2*)p = w; }

struct EpiU {
    bf16_t* U; int ldu; bf16_t* VT; int odd;
    __device__ __forceinline__ void operator()(int row, int col, f32x4 a, f32x4 b) const {
        st_bf16x4(U + (size_t)row * ldu + col, a); st_bf16x4(U + (size_t)row * ldu + col + 128, b);
        if (odd && col >= 2048 && col < 3072) {
#pragma unroll
            for (int i = 0; i < 4; ++i) {
                VT[(size_t)(col - 2048 + i) * NTOK + row] = (bf16_t)(cvt_pk_bf16(a[i], 0.f) & 0xffffu);
                VT[(size_t)(col - 2048 + 128 + i) * NTOK + row] = (bf16_t)(cvt_pk_bf16(b[i], 0.f) & 0xffffu);
            }
        }
    }
};
struct EpiPool {
    bf16_t* AMIX; const float* scale;
    __device__ __forceinline__ void operator()(int row, int col, f32x4 a, f32x4 b) const {
        st_bf16x4(AMIX + (size_t)row * D + 1024 + col, a * *(const f32x4*)(scale + col));
        st_bf16x4(AMIX + (size_t)row * D + 1024 + col + 128, b * *(const f32x4*)(scale + col + 128));
    }
};
struct EpiRes {
    float* X; const float* MODl;
    __device__ __forceinline__ void operator()(int row, int col, f32x4 a, f32x4 b) const {
        const int s = row < NLAT ? row / SEQ : 4;
        const float* g = MODl + (size_t)s * MODW;
        float* x = X + (size_t)row * D + col;
        *(f32x4*)x = *(const f32x4*)x + *(const f32x4*)(g + col) * a;
        *(f32x4*)(x + 128) = *(const f32x4*)(x + 128) + *(const f32x4*)(g + col + 128) * b;
    }
};

__device__ __forceinline__ void conv_phase(const Frame& F, int je) {
    LAS float* part = (LAS float*)F.lds;
    const int ch = 2 * F.tid;
    const float* cw = F.in(9) + (size_t)je * 3 * 1024;
    const float* dw = F.in(10) + (size_t)je * 31 * 1024 + ch;
    const f32x2 dwb = *(const f32x2*)(F.in(11) + (size_t)je * 1024 + ch);
    const f32x2 lng = *(const f32x2*)(F.in(12) + (size_t)je * 1024 + ch);
    const f32x2 lnb = *(const f32x2*)(F.in(13) + (size_t)je * 1024 + ch);
    const f32x2 ca0 = *(const f32x2*)(cw + ch), ca1 = *(const f32x2*)(cw + 1024 + ch), ca2 = *(const f32x2*)(cw + 2048 + ch);
    constexpr int UL = NLAT / 16, UC = NCTX / 16;
    int it = 0;
    unsigned long long cv_acc = 0ull, cv_prev = 0ull;
#define CV_STAMP(k) do { if (NORM2_SUB >= 40 && NORM2_SUB < 50) { const unsigned long long t_ = __builtin_amdgcn_s_memrealtime(); if (NORM2_SUB == (k)) cv_acc += t_ - cv_prev; cv_prev = t_; } } while (0)
#pragma unroll 1
    for (int u = F.bid; u < UL + UC; u += F.G, ++it) {
        int srow0, L, t0;
        if (u < UL) { const int b = u / (SEQ / 16); srow0 = b * SEQ; L = SEQ; t0 = (u % (SEQ / 16)) * 16; }
        else { const int v = u - UL, b = v / (CTXL / 16); srow0 = NLAT + b * CTXL; L = CTXL; t0 = (v % (CTXL / 16)) * 16; }
        CV_STAMP(99);
        const bf16_t* Ub = F.U() + (size_t)srow0 * UE_LD + ch;
        f32x2 z[46];
        {
            unsigned zz[46];
#pragma unroll
            for (int q = 0; q < 46; ++q) { const int t = t0 - 15 + q; zz[q] = (t >= 0 && t < L) ? *(const unsigned*)(Ub + (size_t)t * UE_LD + 2048) : 0u; }
#pragma unroll
            for (int q = 0; q < 46; ++q) { z[q].x = bf_lo(zz[q]); z[q].y = bf_hi(zz[q]); }
        }
        asm volatile("s_waitcnt vmcnt(0)" ::: "memory"); CV_STAMP(40);
        f32x2 zc[16];
#pragma unroll
        for (int t = 0; t < 16; ++t) zc[t] = dwb;
#pragma unroll
        for (int jj = 0; jj < 31; ++jj) {
            const f32x2 w = *(const f32x2*)(dw + (size_t)jj * 1024);
#pragma unroll
            for (int t = 0; t < 16; ++t) zc[t] += w * z[t + jj];
        }
        CV_STAMP(41);
        asm volatile("" : "+v"(zc[0]), "+v"(zc[1]), "+v"(zc[2]), "+v"(zc[3]), "+v"(zc[4]), "+v"(zc[5]), "+v"(zc[6]), "+v"(zc[7]),
                          "+v"(zc[8]), "+v"(zc[9]), "+v"(zc[10]), "+v"(zc[11]), "+v"(zc[12]), "+v"(zc[13]), "+v"(zc[14]), "+v"(zc[15]) :: "memory");
        unsigned cxp[18], bg[16];
#pragma unroll
        for (int q = 0; q < 18; ++q) { const int t = t0 - 1 + q; cxp[q] = (t >= 0 && t < L) ? *(const unsigned*)(Ub + (size_t)t * UE_LD + 1024) : 0u; }
#pragma unroll
        for (int t = 0; t < 16; ++t) bg[t] = *(const unsigned*)(Ub + (size_t)(t0 + t) * UE_LD);
        LAS float* red = part + 512 + (it & 1) * (32 * 528);
        LAS float* pb = part + (it & 1) * 64;
#pragma unroll
        for (int t = 0; t < 16; ++t) { red[(2 * t) * 528 + F.tid] = zc[t].x + zc[t].y; red[(2 * t + 1) * 528 + F.tid] = zc[t].x * zc[t].x + zc[t].y * zc[t].y; }
        __syncthreads();
        { const int v = F.tid >> 4, pr = F.tid & 15; float a = 0.f;
#pragma unroll
          for (int j = 0; j < 32; ++j) a += red[v * 528 + pr + 16 * j];
          a += dpp_f<0xB1>(a); a += dpp_f<0x4E>(a); a += dpp_f<0x141>(a); a += dpp_f<0x140>(a);
          if (pr == 0) pb[v] = a; }
        __syncthreads();
        CV_STAMP(42);
        bf16_t* Ab = F.AMIX() + (size_t)(srow0 + t0) * D + ch;
#pragma unroll
        for (int t = 0; t < 16; ++t) {
            const f32x2 st = *(const LAS f32x2*)(pb + 2 * t);
            const float mu = st.x * (1.0f / 1024.0f); float var = st.y * (1.0f / 1024.0f) - mu * mu; var = var < 0.f ? 0.f : var;
            const float rs = rsqrtf(var + 1e-5f);
            const float y0 = (zc[t].x - mu) * rs * lng.x + lnb.x, y1 = (zc[t].y - mu) * rs * lng.y + lnb.y;
            *(unsigned*)(Ab + (size_t)t * D + 1024) = cvt_pk_bf16(siluf_(y0), siluf_(y1));
        }
        {
            f32x2 cx[18];
#pragma unroll
            for (int q = 0; q < 18; ++q) { cx[q].x = bf_lo(cxp[q]); cx[q].y = bf_hi(cxp[q]); }
#pragma unroll
            for (int t = 0; t < 16; ++t) {
                const f32x2 s = ca0 * cx[t] + ca1 * cx[t + 1] + ca2 * cx[t + 2];
                *(unsigned*)(Ab + (size_t)t * D) = cvt_pk_bf16(bf_lo(bg[t]) * s.x, bf_hi(bg[t]) * s.y);
            }
        }
        CV_STAMP(43);
    }
    if (NORM2_SUB >= 40 && NORM2_SUB < 50 && xb_thread0(F.wave)) atomicMax(F.ctl() + 12288 + 256 + je * 2, (unsigned)cv_acc);
    __syncthreads();
}

template <int W>
__device__ __forceinline__ void mix_tile(const bf16_t* Ub, bf16_t* Mb, int t0, int L) {
    constexpr int NR = 32 + W;
    unsigned v[NR];
#pragma unroll
    for (int i = 0; i < NR; ++i) { const int t = t0 - W / 2 + i; v[i] = (t >= 0 && t < L) ? *(const unsigned*)(Ub + (size_t)t * ODD_IN) : 0u; }
#pragma unroll
    for (int tt = 0; tt < 32; ++tt) {
        float s0 = 0.f, s1 = 0.f;
#pragma unroll
        for (int q = 0; q < W; ++q) { s0 += bf_lo(v[tt + q]); s1 += bf_hi(v[tt + q]); }
        const int t = t0 + tt; int lo = t - W / 2; int hi = lo + W - 1; lo = lo < 0 ? 0 : lo; hi = hi > L - 1 ? L - 1 : hi;
        const float inv = 1.0f / (float)(hi - lo + 1);
        const unsigned pc = v[tt + W / 2];
        *(unsigned*)(Mb + (size_t)tt * 1024) = cvt_pk_bf16(s0 * inv - bf_lo(pc), s1 * inv - bf_hi(pc));
    }
}

constexpr int AT_KLD = 136, AT_VLD = 72;
constexpr int AT_KBYTES = 64 * AT_KLD * 2, AT_VBYTES = 128 * AT_VLD * 2, AT_BUF = AT_KBYTES + AT_VBYTES;
__device__ __forceinline__ void attn_unit(const Frame& F, int jo, int b, int p, int h, bool ctxq, int half, unsigned long long& sub_acc) {
    unsigned long long sprev = (NORM2_SUB >= 20) ? __builtin_amdgcn_s_memrealtime() : 0ull;
#define AT_STAMP(k) do { if (NORM2_SUB >= 20) { const unsigned long long t_ = __builtin_amdgcn_s_memrealtime(); if (NORM2_SUB == (k)) sub_acc += t_ - sprev; sprev = t_; } } while (0)
    const int w = F.wave, lane = F.lane, ql = lane & 15, g = lane >> 4, tid = F.tid;
    const bf16_t* U = F.U(); const bf16_t* VT = F.VT();
    const int kcrow0 = NLAT + b * CTXL;
    int rs_lo = 0, nwin = 0, r_w = 0, my_lo = 0, qrow, qc = 0;
    if (!ctxq) {
        const int r0 = 2 * p, r1 = 2 * p + 1;
        int a0 = r0 - 4; a0 = a0 < 0 ? 0 : (a0 > 24 ? 24 : a0); int a1 = r1 - 4; a1 = a1 < 0 ? 0 : (a1 > 24 ? 24 : a1);
        rs_lo = a0; nwin = a1 + 8 - a0;
        r_w = r0 + (w >> 2); my_lo = (w >> 2) ? a1 : a0;
        qc = 16 * (w & 3) + ql; qrow = b * SEQ + r_w * 64 + qc;
    } else qrow = kcrow0 + half * 128 + 16 * w + ql;
    const int ntile = nwin + 4;
    bf16x8 qf[4];
#pragma unroll
    for (int kk = 0; kk < 4; ++kk) qf[kk] = *(const bf16x8*)(U + (size_t)qrow * ODD_IN + h * 128 + 32 * kk + 8 * g);
    const int kr0 = tid >> 4, kc0 = (tid & 15) * 8, vr0 = tid >> 3, vc0 = (tid & 7) * 8;
    const bf16_t* kg = U + 1024 + h * 128 + kc0;
    const bf16_t* vg = VT + (size_t)(h * 128 + vr0) * NTOK + vc0;
    LAS unsigned char* lbase = F.lds;
    u32x4 kx[2], vx[2];
#define AT_KEYROW(t) ((t) < nwin ? b * SEQ + (rs_lo + (t)) * 64 : kcrow0 + ((t) - nwin) * 64)
#define AT_LOAD(t) do { const int kr_ = AT_KEYROW(t); _Pragma("unroll") for (int p_ = 0; p_ < 2; ++p_) { \
        kx[p_] = *(const u32x4*)(kg + (size_t)(kr_ + kr0 + 32 * p_) * ODD_IN); vx[p_] = *(const u32x4*)(vg + (size_t)(64 * p_) * NTOK + kr_); } } while (0)
#define AT_STORE(buf) do { LAS unsigned char* b_ = lbase + (buf) * AT_BUF; _Pragma("unroll") for (int p_ = 0; p_ < 2; ++p_) { \
        *(LAS u32x4*)(b_ + ((kr0 + 32 * p_) * AT_KLD + kc0) * 2) = kx[p_]; *(LAS u32x4*)(b_ + AT_KBYTES + ((vr0 + 64 * p_) * AT_VLD + vc0) * 2) = vx[p_]; } } while (0)
    LAS float* rpl = (LAS float*)(lbase + 2 * AT_BUF);
    if (!ctxq && tid < 465) rpl[tid] = F.in(16)[(size_t)(jo * 8 + h) * 465 + tid] * 1.4426950408889634f;
    AT_LOAD(0); AT_STORE(0);
    __syncthreads();
    f32x4 o[8];
#pragma unroll
    for (int dt = 0; dt < 8; ++dt) o[dt] = (f32x4){0.f, 0.f, 0.f, 0.f};
    float m = -1.0e30f, lsum = 0.f;
    const float sl2 = 0.08838834764831845f * 1.4426950408889634f;
    int cs = qc - 8; cs = cs < 0 ? 0 : (cs > 48 ? 48 : cs);
#pragma unroll 1
    for (int t = 0; t < ntile; ++t) {
        const bool more = (t + 1 < ntile);
        if (more) AT_LOAD(t + 1);
        const bool win = t < nwin;
        const int jrow = rs_lo + t;
        const bool mine = !win || (jrow >= my_lo && jrow < my_lo + 8);
        AT_STAMP(99);
        if (mine) {
            const LAS unsigned char* kb = lbase + (t & 1) * AT_BUF;
            const LAS unsigned char* vb = kb + AT_KBYTES;
            f32x4 s[4];
            float mx = -1.0e30f;
            if (win) {
                const int nt0 = ((w & 3) >= 2) ? 1 : 0;
                f32x4 sb[3];
#pragma unroll
                for (int q = 0; q < 3; ++q) { sb[q] = (f32x4){0.f, 0.f, 0.f, 0.f};
#pragma unroll
                    for (int kk = 0; kk < 4; ++kk) { const bf16x8 kf = *(const LAS bf16x8*)(kb + ((16 * (nt0 + q) + ql) * AT_KLD + 32 * kk + 8 * g) * 2); sb[q] = __builtin_amdgcn_mfma_f32_16x16x32_bf16(kf, qf[kk], sb[q], 0, 0, 0); } }
                const LAS float* rpb = rpl + (jrow - r_w + 7) * 31 + 15;
#pragma unroll
                for (int q = 0; q < 3; ++q)
#pragma unroll
                    for (int i = 0; i < 4; ++i) {
                        const int kcol = 16 * (nt0 + q) + 4 * g + i;
                        int dc = kcol - qc; dc = dc < -15 ? -15 : (dc > 15 ? 15 : dc);
                        const float tv = sb[q][i] * sl2 + rpb[dc];
                        const float sv = ((unsigned)(kcol - cs) < 16u) ? tv : -1.0e30f;
                        sb[q][i] = sv; mx = fmaxf(mx, sv);
                    }
                const f32x4 neg = (f32x4){-1.0e30f, -1.0e30f, -1.0e30f, -1.0e30f};
                if (nt0) { s[0] = neg; s[1] = sb[0]; s[2] = sb[1]; s[3] = sb[2]; } else { s[0] = sb[0]; s[1] = sb[1]; s[2] = sb[2]; s[3] = neg; }
            } else {
#pragma unroll
                for (int nt = 0; nt < 4; ++nt) { s[nt] = (f32x4){0.f, 0.f, 0.f, 0.f};
#pragma unroll
                    for (int kk = 0; kk < 4; ++kk) { const bf16x8 kf = *(const LAS bf16x8*)(kb + ((16 * nt + ql) * AT_KLD + 32 * kk + 8 * g) * 2); s[nt] = __builtin_amdgcn_mfma_f32_16x16x32_bf16(kf, qf[kk], s[nt], 0, 0, 0); } }
#pragma unroll
                for (int nt = 0; nt < 4; ++nt)
#pragma unroll
                    for (int i = 0; i < 4; ++i) { const float sv = s[nt][i] * sl2; s[nt][i] = sv; mx = fmaxf(mx, sv); }
            }
            mx = fmaxf(mx, shfl_x(mx, 16, lane)); mx = fmaxf(mx, shfl_x(mx, 32, lane));
            AT_STAMP(21);
            const float mn = fmaxf(m, mx), alpha = __builtin_amdgcn_exp2f(m - mn);
            m = mn;
            float ps = 0.f;
#pragma unroll
            for (int nt = 0; nt < 4; ++nt)
#pragma unroll
                for (int i = 0; i < 4; ++i) { const float pv = __builtin_amdgcn_exp2f(s[nt][i] - mn); s[nt][i] = pv; ps += pv; }
            lsum = lsum * alpha + ps;
#pragma unroll
            for (int dt = 0; dt < 8; ++dt) o[dt] *= alpha;
            AT_STAMP(22);
#pragma unroll
            for (int ks = 0; ks < 2; ++ks) {
                u32x4 pk; pk.x = cvt_pk_bf16(s[2 * ks][0], s[2 * ks][1]); pk.y = cvt_pk_bf16(s[2 * ks][2], s[2 * ks][3]); pk.z = cvt_pk_bf16(s[2 * ks + 1][0], s[2 * ks + 1][1]); pk.w = cvt_pk_bf16(s[2 * ks + 1][2], s[2 * ks + 1][3]);
                const bf16x8 pf = __builtin_bit_cast(bf16x8, pk);
#pragma unroll
                for (int dt = 0; dt < 8; ++dt) {
                    const LAS unsigned char* vp = vb + ((16 * dt + ql) * AT_VLD + 32 * ks + 4 * g) * 2;
                    const u32x2 v0 = *(const LAS u32x2*)vp, v1 = *(const LAS u32x2*)(vp + 32);
                    u32x4 vv; vv.x = v0.x; vv.y = v0.y; vv.z = v1.x; vv.w = v1.y;
                    o[dt] = __builtin_amdgcn_mfma_f32_16x16x32_bf16(__builtin_bit_cast(bf16x8, vv), pf, o[dt], 0, 0, 0);
                }
            }
        }
        AT_STAMP(23);
        if (more) AT_STORE((t + 1) & 1);
        __syncthreads();
        AT_STAMP(20);
    }
#undef AT_KEYROW
#undef AT_LOAD
#undef AT_STORE
    lsum += shfl_x(lsum, 16, lane); lsum += shfl_x(lsum, 32, lane);
    const float inv = 1.0f / lsum;
    bf16_t* op = F.AMIX() + (size_t)qrow * D + h * 128 + 4 * g;
#pragma unroll
    for (int dt = 0; dt < 8; ++dt) st_bf16x4(op + 16 * dt, o[dt] * inv);
}

__device__ __forceinline__ void attn_mix_phase(const Frame& F, int l) {
    const int jo = l >> 1;
    const bool last = (l == DEPTH - 1);
    const int nA = NB * 16 * 8, nC = last ? 0 : NB * 2 * 8, nMix = (last ? NLAT : NTOK) / 32;
    unsigned long long sub_acc = 0ull;
#pragma unroll 1
    for (int u = F.bid; u < nA + nC + nMix; u += F.G) {
        if (u < nA + nC) {
            if (u < nA) attn_unit(F, jo, u >> 7, (u >> 3) & 15, u & 7, false, 0, sub_acc);
            else { const int v = u - nA; attn_unit(F, jo, v >> 4, 0, v & 7, true, (v >> 3) & 1, sub_acc); }
        } else {
            const int row0 = (u - nA - nC) * 32;
            int srow0, L;
            if (row0 < NLAT) { srow0 = (row0 / SEQ) * SEQ; L = SEQ; } else { srow0 = NLAT + ((row0 - NLAT) / CTXL) * CTXL; L = CTXL; }
            const int ch = 2 * F.tid, g = F.wave >> 1;
            const bf16_t* Ub = F.U() + (size_t)srow0 * ODD_IN + 3072 + ch;
            bf16_t* Mb = F.MIX() + (size_t)row0 * 1024 + ch;
            const int t0 = row0 - srow0;
            if (g == 0) mix_tile<2>(Ub, Mb, t0, L); else if (g == 1) mix_tile<4>(Ub, Mb, t0, L); else if (g == 2) mix_tile<8>(Ub, Mb, t0, L); else mix_tile<16>(Ub, Mb, t0, L);
        }
    }
    if (NORM2_SUB >= 20 && NORM2_SUB < 30 && xb_thread0(F.wave)) atomicMax(F.ctl() + 12288 + 256 + l, (unsigned)sub_acc);
}

namespace pg8 {
constexpr int BM = 256, BK = 64, HALF = 128, HTB = HALF * BK * 2, STAGE_BYTES = 8 * HTB, NXCD = 8, WGM = 8;
__device__ __forceinline__ int lds_byte(int r, int c) { const int st = (r >> 4) * 2 + (c >> 5), rr = r & 15, cc = c & 31, ob = rr * 64 + cc * 2; return st * 1024 + (ob ^ (((ob >> 9) & 1) << 5)); }
__device__ __forceinline__ void stage_rc(int b, int& R, int& C) { const int st = b / 1024, sb = b % 1024, swz = sb ^ (((sb >> 9) & 1) << 5); R = (st >> 1) * 16 + swz / 64; C = (st & 1) * 32 + (swz % 64) / 2; }
struct Unit { int pm, pn, aux; };

struct DenseSched {
    const char* A; const char* Bt; int lda, ldb, a_pn_off; int nM, nN, nwg, G, c;
    __device__ __forceinline__ void init(const void* A_, int lda_, int a_pn_off_, const void* Bt_, int ldb_, int M, int N, int G_, int c_) {
        A = (const char*)A_; Bt = (const char*)Bt_; lda = lda_; ldb = ldb_; a_pn_off = a_pn_off_; nM = M / BM; nN = N / BM; nwg = nM * nN; G = G_; c = c_; }
    __device__ __forceinline__ bool next(int i, Unit& u) const {
        const long L = (long)i * G + c; if (L >= nwg) return false;
        int wgid = (int)L; { const int q = nwg / NXCD, r = nwg % NXCD, xcd = wgid % NXCD, off = wgid / NXCD; wgid = (xcd < r ? xcd * (q + 1) : r * (q + 1) + (xcd - r) * q) + off; }
        const int nig = WGM * nN, gid = wgid / nig, fm = gid * WGM, gsz = (nM - fm) < WGM ? (nM - fm) : WGM;
        u.pm = fm + ((wgid % nig) % gsz); u.pn = (wgid % nig) / gsz; u.aux = 0; return true;
    }
    __device__ __forceinline__ const char* a_ptr(const Unit& u) const { return A + ((size_t)u.pm * BM * lda + (size_t)u.pn * a_pn_off) * 2; }
    __device__ __forceinline__ const char* b_ptr(const Unit& u) const { return Bt + (size_t)u.pn * BM * ldb * 2; }
    __device__ __forceinline__ void a_gather(const Unit&, int, unsigned (&)[2][2]) const {}
};

template <class Epi, class Sched, bool GATHER, int TAG = -100>
__device__ __forceinline__ void gemm_phase(LAS unsigned char* lds, const int tid, const int K, const int lda, const int ldb, const Sched& S, const Epi& E, unsigned* tword = nullptr) {
    unsigned long long epi_t = 0ull; const unsigned long long g_t0 = (NORM2_SUB == TAG + 1) ? __builtin_amdgcn_s_memrealtime() : 0ull;
    const int wid = __builtin_amdgcn_readfirstlane(tid >> 6), lane = tid & 63, wr = wid >> 2, wc = wid & 3, fr = lane & 15, fq = lane >> 4;
    const int nt = K / BK;
    unsigned voffA[2], voffB[2];
#pragma unroll
    for (int i = 0; i < 2; ++i) { int R, C; stage_rc(tid * 16 + i * 8192, R, C);
        voffA[i] = (unsigned)(R * lda + C) * 2u; voffB[i] = (unsigned)(R * ldb + C) * 2u; }
    const size_t kstep = (size_t)(BK * 2);
    const size_t hstepA = (size_t)HALF * lda * 2, hstepB = (size_t)HALF * ldb * 2;
    const unsigned ldsw = (unsigned)wid * 1024u;
    const int aoff = lds_byte(wr * 64 + fr, fq * 8), boff = lds_byte(wc * 32 + fr, fq * 8);
#define PG8_SA(b, h) (((b) * 2 + (h)) * HTB)
#define PG8_SB(b, h) ((4 + (b) * 2 + (h)) * HTB)
#define PG8_STAGE(bufoff, gbase, voff) do { _Pragma("unroll") for (int _i = 0; _i < 2; ++_i) \
        __builtin_amdgcn_global_load_lds((const unsigned*)((const char*)(gbase) + (voff)[_i]), (LAS unsigned*)(lds + (bufoff) + ldsw + _i * 8192), 16, 0, 0); } while (0)
#define PG8_STAGE_A(b, h, kptr, G) do { if constexpr (GATHER) PG8_STAGE(PG8_SA(b, h), kptr, (G)[h]); else PG8_STAGE(PG8_SA(b, h), (kptr) + (h) * hstepA, voffA); } while (0)
#define PG8_LDA(dst, b, h) do { _Pragma("unroll") for (int m = 0; m < 4; ++m) _Pragma("unroll") for (int k = 0; k < 2; ++k) dst[m][k] = *(const LAS bf16x8*)(lds + PG8_SA(b, h) + aoff + m * 2048 + k * 1024); } while (0)
#define PG8_LDB(dst, b, h) do { _Pragma("unroll") for (int n = 0; n < 2; ++n) _Pragma("unroll") for (int k = 0; k < 2; ++k) dst[n][k] = *(const LAS bf16x8*)(lds + PG8_SB(b, h) + boff + n * 2048 + k * 1024); } while (0)
#define PG8_MMA(ai, bj, At, Bt) do { __builtin_amdgcn_s_setprio(1); _Pragma("unroll") for (int m = 0; m < 4; ++m) _Pragma("unroll") for (int n = 0; n < 2; ++n) _Pragma("unroll") for (int k = 0; k < 2; ++k) \
        acc[ai][bj][m][n] = __builtin_amdgcn_mfma_f32_16x16x32_bf16(Bt[n][k], At[m][k], acc[ai][bj][m][n], 0, 0, 0); __builtin_amdgcn_s_setprio(0); } while (0)
#define PG8_WAIT_V(n) asm volatile("s_waitcnt vmcnt(" #n ")" ::: "memory")
#define PG8_WAIT_L(n) asm volatile("s_waitcnt lgkmcnt(" #n ")" ::: "memory")
#define PG8_BAR __builtin_amdgcn_s_barrier()
#define PG8_SCHED __builtin_amdgcn_sched_barrier(0)
    Unit cur, nxt; int ui = 0;
    if (!S.next(0, cur)) return;
    f32x4 acc[2][2][4][2];
#pragma unroll
    for (int a = 0; a < 2; ++a)
#pragma unroll
        for (int b = 0; b < 2; ++b)
#pragma unroll
            for (int m = 0; m < 4; ++m)
#pragma unroll
                for (int n = 0; n < 2; ++n) acc[a][b][m][n] = (f32x4){0.f, 0.f, 0.f, 0.f};
    bf16x8 At[4][2], B0[2][2], B1[2][2];
    const char* cA = S.a_ptr(cur); const char* cB = S.b_ptr(cur);
    unsigned gcur[2][2] = {{0u, 0u}, {0u, 0u}}, gnx[2][2] = {{0u, 0u}, {0u, 0u}};
    if constexpr (GATHER) S.a_gather(cur, tid, gcur);
    PG8_STAGE(PG8_SB(0, 0), cB, voffB); PG8_STAGE_A(0, 0, cA, gcur); PG8_STAGE(PG8_SB(0, 1), cB + hstepB, voffB); PG8_STAGE_A(0, 1, cA, gcur);
    if (wr == 1) PG8_BAR;
    PG8_WAIT_V(4); PG8_BAR;
    PG8_STAGE(PG8_SB(1, 0), cB + kstep, voffB); PG8_STAGE_A(1, 0, cA + kstep, gcur); PG8_STAGE(PG8_SB(1, 1), cB + hstepB + kstep, voffB);
    PG8_WAIT_V(6); PG8_BAR;
    for (;;) {
        const bool has_next = S.next(ui + 1, nxt);
        const char* nA = has_next ? S.a_ptr(nxt) : cA; const char* nB = has_next ? S.b_ptr(nxt) : cB;

#pragma unroll 1
        for (int t = 0; t < nt; t += 2) {
            const bool last = (t == nt - 2);
            const char* a1 = cA + (size_t)(t + 1) * kstep;
            const char* a2 = last ? nA : cA + (size_t)(t + 2) * kstep; const char* b2 = last ? nB : cB + (size_t)(t + 2) * kstep;
            const char* a3 = a2 + kstep; const char* b3 = b2 + kstep;
            unsigned g2[2][2];
#pragma unroll
            for (int h = 0; h < 2; ++h)
#pragma unroll
                for (int i = 0; i < 2; ++i) g2[h][i] = gcur[h][i];
            if constexpr (GATHER) { if (last && has_next) { S.a_gather(nxt, tid, gnx);
#pragma unroll
                for (int h = 0; h < 2; ++h)
#pragma unroll
                    for (int i = 0; i < 2; ++i) g2[h][i] = gnx[h][i]; } }
            PG8_LDB(B0, 0, 0); PG8_SCHED; PG8_LDA(At, 0, 0); PG8_STAGE_A(1, 1, a1, gcur);
            PG8_WAIT_L(8); PG8_BAR; PG8_WAIT_L(0); PG8_MMA(0, 0, At, B0); PG8_BAR; PG8_SCHED;
            PG8_LDB(B1, 0, 1); PG8_STAGE(PG8_SB(0, 0), b2, voffB);
            PG8_BAR; PG8_WAIT_L(0); PG8_MMA(0, 1, At, B1); PG8_BAR;
            PG8_LDA(At, 0, 1); PG8_STAGE_A(0, 0, a2, g2);
            PG8_BAR; PG8_WAIT_L(0); PG8_MMA(1, 0, At, B0); PG8_BAR; PG8_SCHED;
            PG8_STAGE(PG8_SB(0, 1), b2 + hstepB, voffB);
            PG8_WAIT_V(6); PG8_BAR; PG8_MMA(1, 1, At, B1); PG8_BAR;
            PG8_LDB(B0, 1, 0); PG8_SCHED; PG8_LDA(At, 1, 0); PG8_STAGE_A(0, 1, a2, g2);
            PG8_WAIT_L(8); PG8_BAR; PG8_WAIT_L(0); PG8_MMA(0, 0, At, B0); PG8_BAR; PG8_SCHED;
            PG8_LDB(B1, 1, 1); PG8_STAGE(PG8_SB(1, 0), b3, voffB);
            PG8_BAR; PG8_WAIT_L(0); PG8_MMA(0, 1, At, B1); PG8_BAR;
            PG8_LDA(At, 1, 1); PG8_STAGE_A(1, 0, a3, g2);
            PG8_BAR; PG8_WAIT_L(0); PG8_MMA(1, 0, At, B0); PG8_BAR; PG8_SCHED;
            PG8_STAGE(PG8_SB(1, 1), b3 + hstepB, voffB);
            PG8_WAIT_V(6); PG8_BAR; PG8_MMA(1, 1, At, B1); PG8_BAR;
        }
        if (NORM2_SUB == TAG) { const unsigned long long e0 = __builtin_amdgcn_s_memrealtime(); E(acc, cur, wr, wc, fr, fq); asm volatile("s_waitcnt vmcnt(0)" ::: "memory"); epi_t += __builtin_amdgcn_s_memrealtime() - e0; }
        else E(acc, cur, wr, wc, fr, fq);
        if (!has_next) break;
#pragma unroll
        for (int a = 0; a < 2; ++a)
#pragma unroll
            for (int b = 0; b < 2; ++b)
#pragma unroll
                for (int m = 0; m < 4; ++m)
#pragma unroll
                    for (int n = 0; n < 2; ++n) acc[a][b][m][n] = (f32x4){0.f, 0.f, 0.f, 0.f};
        cur = nxt; cA = nA; cB = nB; ++ui;
        if constexpr (GATHER) {
#pragma unroll
            for (int h = 0; h < 2; ++h)
#pragma unroll
                for (int i = 0; i < 2; ++i) gcur[h][i] = gnx[h][i]; }
    }
    PG8_WAIT_V(0);
    if (wr == 0) PG8_BAR;
    PG8_BAR;
    if ((NORM2_SUB == TAG || NORM2_SUB == TAG + 1) && tword && tid == 0) atomicMax(tword, (unsigned)(NORM2_SUB == TAG ? epi_t : __builtin_amdgcn_s_memrealtime() - g_t0));
#undef PG8_SA
#undef PG8_SB
#undef PG8_STAGE
#undef PG8_STAGE_A
#undef PG8_LDA
#undef PG8_LDB
#undef PG8_MMA
#undef PG8_WAIT_V
#undef PG8_WAIT_L
#undef PG8_BAR
#undef PG8_SCHED
}
}

struct FEpiU {
    bf16_t* U; int ldu; bf16_t* VT; int odd;
    __device__ __forceinline__ void operator()(const f32x4 (&acc)[2][2][4][2], const pg8::Unit& u, int wr, int wc, int fr, int fq) const {
        const int row0 = u.pm * 256 + wr * 64 + fr, col0 = u.pn * 256 + wc * 32 + 4 * fq;
        const bool vt = odd && col0 >= 2048 && col0 < 3072;
#pragma unroll
        for (int ai = 0; ai < 2; ++ai)
#pragma unroll
            for (int m = 0; m < 4; ++m) {
                const int row = row0 + ai * 128 + m * 16;
                bf16_t* rowp = U + (size_t)row * ldu + col0;
#pragma unroll
                for (int bj = 0; bj < 2; ++bj)
#pragma unroll
                    for (int n = 0; n < 2; ++n) {
                        const f32x4 v = acc[ai][bj][m][n];
                        st_bf16x4(rowp + bj * 128 + n * 16, v);
                        if (vt) {
#pragma unroll
                            for (int i = 0; i < 4; ++i) VT[(size_t)(col0 - 2048 + bj * 128 + n * 16 + i) * NTOK + row] = (bf16_t)(cvt_pk_bf16(v[i], 0.f) & 0xffffu);
                        }
                    }
            }
    }
};
struct FEpiUE {
    bf16_t* U;
    __device__ __forceinline__ void operator()(const f32x4 (&acc)[2][2][4][2], const pg8::Unit& u, int wr, int wc, int fr, int fq) const {
        const int row0 = u.pm * 256 + wr * 64 + fr, c0 = wc * 32 + 4 * fq;
        if (u.pn < 4) {
#pragma unroll
            for (int ai = 0; ai < 2; ++ai)
#pragma unroll
                for (int m = 0; m < 4; ++m) { bf16_t* rowp = U + (size_t)(row0 + ai * 128 + m * 16) * UE_LD + u.pn * 256 + c0;
#pragma unroll
                    for (int bj = 0; bj < 2; ++bj)
#pragma unroll
                        for (int n = 0; n < 2; ++n) st_bf16x4(rowp + bj * 128 + n * 16, acc[ai][bj][m][n]); }
        } else {
            const bool glu = u.pn >= 12;
            const int colb = (glu ? 2048 + (u.pn - 12) * 128 : 1024 + (u.pn - 4) * 128) + c0;
#pragma unroll
            for (int ai = 0; ai < 2; ++ai)
#pragma unroll
                for (int m = 0; m < 4; ++m) { bf16_t* rowp = U + (size_t)(row0 + ai * 128 + m * 16) * UE_LD + colb;
#pragma unroll
                    for (int n = 0; n < 2; ++n) { const f32x4 a = acc[ai][0][m][n], b = acc[ai][1][m][n]; f32x4 v;
#pragma unroll
                        for (int i = 0; i < 4; ++i) v[i] = glu ? a[i] * sigmoidf_(b[i]) : a[i] * b[i];
                        st_bf16x4(rowp + n * 16, v); } }
        }
    }
};
struct FEpiPool {
    bf16_t* AMIX; const float* scale;
    __device__ __forceinline__ void operator()(const f32x4 (&acc)[2][2][4][2], const pg8::Unit& u, int wr, int wc, int fr, int fq) const {
        const int row0 = u.pm * 256 + wr * 64 + fr, col0 = u.pn * 256 + wc * 32 + 4 * fq;
        f32x4 sc[2][2];
#pragma unroll
        for (int bj = 0; bj < 2; ++bj)
#pragma unroll
            for (int n = 0; n < 2; ++n) sc[bj][n] = *(const f32x4*)(scale + col0 + bj * 128 + n * 16);
#pragma unroll
        for (int bj = 0; bj < 2; ++bj)
#pragma unroll
            for (int n = 0; n < 2; ++n)
#pragma unroll
                for (int ai = 0; ai < 2; ++ai)
#pragma unroll
                    for (int m = 0; m < 4; ++m) st_bf16x4(AMIX + (size_t)(row0 + ai * 128 + m * 16) * D + 1024 + col0 + bj * 128 + n * 16, acc[ai][bj][m][n] * sc[bj][n]);
    }
};
struct FEpiRes {
    float* X; const float* MODl;
    __device__ __forceinline__ void operator()(const f32x4 (&acc)[2][2][4][2], const pg8::Unit& u, int wr, int wc, int fr, int fq) const {
        const int row0 = u.pm * 256 + wr * 64 + fr, col0 = u.pn * 256 + wc * 32 + 4 * fq;
        const int s = u.pm < 32 ? (u.pm >> 3) : 4;
        const float* g = MODl + (size_t)s * MODW + col0;
        f32x4 gv[2][2];
#pragma unroll
        for (int bj = 0; bj < 2; ++bj)
#pragma unroll
            for (int n = 0; n < 2; ++n) gv[bj][n] = *(const f32x4*)(g + bj * 128 + n * 16);
#pragma unroll
        for (int ai = 0; ai < 2; ++ai)
#pragma unroll
            for (int mp = 0; mp < 2; ++mp) {
                float* p0 = X + (size_t)(row0 + ai * 128 + (2 * mp) * 16) * D + col0;
                float* p1 = p0 + (size_t)16 * D;
                f32x4 x0, x1, x2, x3, x4, x5, x6, x7;
                asm volatile("global_load_dwordx4 %0, %8, off\n\tglobal_load_dwordx4 %1, %8, off offset:64\n\tglobal_load_dwordx4 %2, %8, off offset:512\n\tglobal_load_dwordx4 %3, %8, off offset:576\n\t"
                             "global_load_dwordx4 %4, %9, off\n\tglobal_load_dwordx4 %5, %9, off offset:64\n\tglobal_load_dwordx4 %6, %9, off offset:512\n\tglobal_load_dwordx4 %7, %9, off offset:576\n\t"
                             "s_waitcnt vmcnt(0)"
                             : "=&v"(x0), "=&v"(x1), "=&v"(x2), "=&v"(x3), "=&v"(x4), "=&v"(x5), "=&v"(x6), "=&v"(x7) : "v"(p0), "v"(p1) : "memory");
                *(f32x4*)(p0)       = x0 + gv[0][0] * acc[ai][0][2 * mp][0];
                *(f32x4*)(p0 + 16)  = x1 + gv[0][1] * acc[ai][0][2 * mp][1];
                *(f32x4*)(p0 + 128) = x2 + gv[1][0] * acc[ai][1][2 * mp][0];
                *(f32x4*)(p0 + 144) = x3 + gv[1][1] * acc[ai][1][2 * mp][1];
                *(f32x4*)(p1)       = x4 + gv[0][0] * acc[ai][0][2 * mp + 1][0];
                *(f32x4*)(p1 + 16)  = x5 + gv[0][1] * acc[ai][0][2 * mp + 1][1];
                *(f32x4*)(p1 + 128) = x6 + gv[1][0] * acc[ai][1][2 * mp + 1][0];
                *(f32x4*)(p1 + 144) = x7 + gv[1][1] * acc[ai][1][2 * mp + 1][1];
            }
    }
};

__device__ __forceinline__ void moe_tiles(const Frame& F, int l, LAS int* ts) {
    if (F.tid < NEXP) ts[33 + F.tid] = (int)__hip_atomic_load(F.ctl() + CW_CNT + l * 32 + F.tid, __ATOMIC_RELAXED, __HIP_MEMORY_SCOPE_AGENT);
    __syncthreads();
    if (F.tid == 0) { int acc = 0;
        for (int e = 0; e < NEXP; ++e) { ts[e] = acc; acc += (ts[33 + e] + 255) >> 8; }
        ts[32] = acc; }
    __syncthreads();
}
__device__ __forceinline__ int moe_find(const LAS int* ts, int ti) { int e = 0;
#pragma unroll 1
    for (int q = 1; q < NEXP; ++q) e = (ts[q] <= ti) ? q : e;
    return e; }

__device__ __forceinline__ void moe_up_phase(const Frame& F, int l) {
    LAS int* ts = (LAS int*)(F.lds + 1024);
    moe_tiles(F, l, ts);
    const int T = ts[32], fr = F.lane & 15, fq = F.lane >> 4;
#pragma unroll 1
    for (int u = F.bid; u < T * 8; u += F.G) {
        const int ti = u >> 3, q = (u >> 1) & 3, pn = u & 1;
        const int e = moe_find(ts, ti), j = ti - ts[e], cnt = ts[33 + e];
        const int* sl = F.SLOT() + (size_t)e * SLOT_CAP;
        const bf16_t* ap[4]; int sv[4];
#pragma unroll
        for (int m = 0; m < 4; ++m) { const int li = j * 256 + q * 64 + m * 16 + fr; sv[m] = li < cnt ? sl[li] : -1; const int tok = sv[m] < 0 ? 0 : (sv[m] >> 1); ap[m] = F.H() + (size_t)tok * D + 8 * fq; }
        const bf16_t* Bt = F.W13() + ((size_t)l * NEXP + e) * 512 * D;
        const bf16_t* bp0 = Bt + (size_t)(pn * 256 + F.wave * 16 + fr) * D + 8 * fq;
        const bf16_t* bp1 = bp0 + (size_t)128 * D;
        f32x4 a[4], b[4];
        sgemm_core(ap, bp0, bp1, D, a, b);
#pragma unroll
        for (int m = 0; m < 4; ++m) {
            const float gate = sv[m] < 0 ? 0.f : F.TOKG()[sv[m]];
            f32x4 hv;
#pragma unroll
            for (int i = 0; i < 4; ++i) hv[i] = sv[m] < 0 ? 0.f : siluf_(a[m][i]) * b[m][i] * gate;
            st_bf16x4(F.HID() + (size_t)(ti * 256 + q * 64 + m * 16 + fr) * FF + pn * 128 + F.wave * 16 + 4 * fq, hv);
        }
    }
}
__device__ __forceinline__ void moe_down_phase(const Frame& F, int l) {
    LAS int* ts = (LAS int*)(F.lds + 1024);
    moe_tiles(F, l, ts);
    const int T = ts[32], fr = F.lane & 15, fq = F.lane >> 4;
#pragma unroll 1
    for (int u = F.bid; u < T * 32; u += F.G) {
        const int ti = u >> 5, q = (u >> 3) & 3, pn = u & 7;
        const int e = moe_find(ts, ti), j = ti - ts[e], cnt = ts[33 + e];
        const int* sl = F.SLOT() + (size_t)e * SLOT_CAP;
        const bf16_t* ap[4]; int sv[4];
#pragma unroll
        for (int m = 0; m < 4; ++m) { const int li = j * 256 + q * 64 + m * 16 + fr; sv[m] = li < cnt ? sl[li] : -1; ap[m] = F.HID() + (size_t)(ti * 256 + q * 64 + m * 16 + fr) * FF + 8 * fq; }
        const bf16_t* Bt = F.W2() + ((size_t)l * NEXP + e) * D * FF;
        const bf16_t* bp0 = Bt + (size_t)(pn * 256 + F.wave * 16 + fr) * FF + 8 * fq;
        const bf16_t* bp1 = bp0 + (size_t)128 * FF;
        f32x4 a[4], b[4];
        sgemm_core(ap, bp0, bp1, FF, a, b);
#pragma unroll
        for (int m = 0; m < 4; ++m) if (sv[m] >= 0) {
            bf16_t* y = F.Y2() + (size_t)sv[m] * D + pn * 256 + F.wave * 16 + 4 * fq;
            st_bf16x4(y, a[m]); st_bf16x4(y + 128, b[m]);
        }
    }
}

constexpr int LDS_TS = 131072;
struct MoeSched {
    const LAS int* ts; int T, NPN, G, c;
    const char* Abase; const char* Bbase; size_t b_estride, b_pnstride, a_tstride; const int* SLOT; int lda;
    __device__ __forceinline__ int xcd_count(int x) const { const int nu = T * NPN, per = (nu + 7) >> 3; int n = nu - x * per; return n < 0 ? 0 : (n > per ? per : n); }
    __device__ __forceinline__ bool next(int i, pg8::Unit& u) const {
        int idx;
        if ((G & 7) == 0) { const int per = (T * NPN + 7) >> 3, x = c & 7, k = (c >> 3) + i * (G >> 3); if (k >= xcd_count(x)) return false; idx = x * per + k; }
        else { idx = i * G + c; if (idx >= T * NPN) return false; }
        const int ti = idx / NPN; u.pm = ti; u.pn = idx - ti * NPN; u.aux = moe_find(ts, ti); return true; }
    __device__ __forceinline__ int idle_rank() const {
        if ((G & 7) != 0) return c >= T * NPN ? c - T * NPN : -1;
        const int x = c & 7, slot = c >> 3, per8 = G >> 3; if (slot < xcd_count(x)) return -1;
        int r = slot - xcd_count(x);
        for (int xx = 0; xx < x; ++xx) r += per8 - (xcd_count(xx) < per8 ? xcd_count(xx) : per8);
        return r; }
    __device__ __forceinline__ const char* a_ptr(const pg8::Unit& u) const { return Abase + (size_t)u.pm * a_tstride; }
    __device__ __forceinline__ const char* b_ptr(const pg8::Unit& u) const { return Bbase + (size_t)u.aux * b_estride + (size_t)u.pn * b_pnstride; }
    __device__ __forceinline__ void a_gather(const pg8::Unit& u, int tid, unsigned (&off)[2][2]) const {
        const int e = u.aux, j = u.pm - ts[e], cnt = ts[33 + e];
        const int* sl = SLOT + (size_t)e * SLOT_CAP + j * 256;
#pragma unroll
        for (int i = 0; i < 2; ++i) { int R, C; pg8::stage_rc(tid * 16 + i * 8192, R, C);
#pragma unroll
            for (int h = 0; h < 2; ++h) { const int li = h * 128 + R; const int tok = (j * 256 + li < cnt) ? (sl[li] >> 1) : 0; off[h][i] = (unsigned)(tok * lda + C) * 2u; } }
    }
};
template <class S0> struct OneUnitSched {
    const S0& s; int i0;
    __device__ __forceinline__ bool next(int i, pg8::Unit& u) const { if (i != 0) return false; return s.next(i0, u); }
    __device__ __forceinline__ const char* a_ptr(const pg8::Unit& u) const { return s.a_ptr(u); }
    __device__ __forceinline__ const char* b_ptr(const pg8::Unit& u) const { return s.b_ptr(u); }
    __device__ __forceinline__ void a_gather(const pg8::Unit& u, int tid, unsigned (&off)[2][2]) const { s.a_gather(u, tid, off); }
};
struct FEpiUp {
    bf16_t* HID; const float* SLOTG; const LAS int* ts;
    __device__ __forceinline__ void operator()(const f32x4 (&acc)[2][2][4][2], const pg8::Unit& u, int wr, int wc, int fr, int fq) const {
        const int e = u.aux, j = u.pm - ts[e], cnt = ts[33 + e];
        const float* sg = SLOTG + (size_t)e * SLOT_CAP + j * 256;
#pragma unroll
        for (int ai = 0; ai < 2; ++ai) {
            float gates[4];
#pragma unroll
            for (int m = 0; m < 4; ++m) { const int r = ai * 128 + wr * 64 + m * 16 + fr; gates[m] = (j * 256 + r < cnt) ? sg[r] : 0.f; }
#pragma unroll
            for (int m = 0; m < 4; ++m) {
                const int r = ai * 128 + wr * 64 + m * 16 + fr;
                const float gate = gates[m];
                bf16_t* hp = HID + (size_t)(u.pm * 256 + r) * FF + u.pn * 128 + wc * 32 + 4 * fq;
#pragma unroll
                for (int n = 0; n < 2; ++n) { const f32x4 a = acc[ai][0][m][n], b = acc[ai][1][m][n]; f32x4 hv;
#pragma unroll
                    for (int i = 0; i < 4; ++i) hv[i] = siluf_(a[i]) * b[i] * gate;
                    st_bf16x4(hp + n * 16, hv); }
            }
        }
    }
};
struct FEpiDown {
    bf16_t* Y2; const int* SLOT; const LAS int* ts;
    __device__ __forceinline__ void operator()(const f32x4 (&acc)[2][2][4][2], const pg8::Unit& u, int wr, int wc, int fr, int fq) const {
        const int e = u.aux, j = u.pm - ts[e], cnt = ts[33 + e];
        const int* sl = SLOT + (size_t)e * SLOT_CAP + j * 256;
        int svs[2][4];
#pragma unroll
        for (int ai = 0; ai < 2; ++ai)
#pragma unroll
            for (int m = 0; m < 4; ++m) { const int r = ai * 128 + wr * 64 + m * 16 + fr; svs[ai][m] = (j * 256 + r < cnt) ? sl[r] : -1; }
#pragma unroll
        for (int ai = 0; ai < 2; ++ai)
#pragma unroll
            for (int m = 0; m < 4; ++m) {
                if (svs[ai][m] >= 0) {
                    bf16_t* yp = Y2 + (size_t)svs[ai][m] * D + u.pn * 256 + wc * 32 + 4 * fq;
#pragma unroll
                    for (int bj = 0; bj < 2; ++bj)
#pragma unroll
                        for (int n = 0; n < 2; ++n) st_bf16x4(yp + bj * 128 + n * 16, acc[ai][bj][m][n]);
                }
            }
    }
};
__device__ __forceinline__ void moe_up_fast(const Frame& F, int l) {
    LAS int* ts = (LAS int*)(F.lds + LDS_TS);
    moe_tiles(F, l, ts);
    MoeSched S; S.ts = ts; S.T = ts[32]; S.NPN = 2; S.G = F.G; S.c = F.bid;
    S.Abase = (const char*)F.H(); S.a_tstride = 0; S.Bbase = (const char*)(F.W13() + (size_t)l * NEXP * 512 * D); S.b_estride = (size_t)512 * D * 2; S.b_pnstride = (size_t)256 * D * 2;
    S.SLOT = F.SLOT(); S.lda = D;
    FEpiUp E{F.HID(), F.SLOTG(), ts};
#pragma unroll 1
    for (int i0 = 0; ; ++i0) { pg8::Unit u0; if (!S.next(i0, u0)) break;
        OneUnitSched<MoeSched> S1{S, i0};
        pg8::gemm_phase<FEpiUp, OneUnitSched<MoeSched>, true>(F.lds, F.tid, D, D, D, S1, E); }
    if (l + 1 < DEPTH && F.G == 256) { const CvtPlan cp = cvt_plan(l, F.G); const int nu = S.T * 2;
        if (nu < F.G) { const int ir = S.idle_rank(); if (ir >= 0) convert_layer(F, l + 1, ir, F.G - nu, cp.u_lo, cp.nt); } else convert_layer(F, l + 1, F.bid, F.G, cp.u_lo, cp.nt); }
}
__device__ __forceinline__ void moe_down_fast(const Frame& F, int l) {
    LAS int* ts = (LAS int*)(F.lds + LDS_TS);
    moe_tiles(F, l, ts);
    MoeSched S; S.ts = ts; S.T = ts[32]; S.NPN = 8; S.G = F.G; S.c = F.bid;
    S.Abase = (const char*)F.HID(); S.a_tstride = (size_t)256 * FF * 2; S.Bbase = (const char*)(F.W2() + (size_t)l * NEXP * D * FF); S.b_estride = (size_t)D * FF * 2; S.b_pnstride = (size_t)256 * FF * 2;
    S.SLOT = F.SLOT(); S.lda = FF;
    FEpiDown E{F.Y2(), F.SLOT(), ts};
    pg8::gemm_phase<FEpiDown, MoeSched, false>(F.lds, F.tid, FF, FF, FF, S, E);
}

__global__ void __launch_bounds__(512, 2) hybrid_fwd(Args args) {
    extern __shared__ __attribute__((aligned(16))) unsigned char lds_raw[];
    Frame F;
    F.lds = (LAS unsigned char*)lds_raw;
    F.tid = threadIdx.x; F.lane = F.tid & 63; F.wave = __builtin_amdgcn_readfirstlane(F.tid >> 6);
    F.G = gridDim.x; F.bid = blockIdx.x;
    F.ka = (const CAS Args*)__builtin_amdgcn_kernarg_segment_ptr();

    volatile LAS unsigned* misc = (volatile LAS unsigned*)(F.lds + LDS_MISC);
    if (F.tid < 64) misc[F.tid] = 0u;
    __syncthreads();
    XcdBarrier bar; bar.bar = F.ctl(); bar.x = 0; bar.st = misc; bar.wave = F.wave;
#if MK_N_LAUNCHES == 1
    bar = xcd_barrier_post(F.ctl(), misc);
#endif
    const int lo = F.ka->ph_lo, hi = F.ka->ph_hi;
    int ph = 0;
    constexpr int CW_PR = 12288;
#define PROBE_MARK(kind) do { if (PROBE_KA >= 0) { if (xb_thread0(F.wave)) { int b_ = F.bid; asm volatile("" : "+s"(b_)); const unsigned t_ = (unsigned)__builtin_amdgcn_s_memrealtime(); atomicMax(F.ctl() + CW_PR + ph, t_); atomicMax(F.ctl() + CW_PR + 64 + ph, ~t_); \
        if (b_ == 0) F.ctl()[CW_PR + 128 + ph] = (unsigned)((kind) + 1); } } } while (0)
#if MK_N_LAUNCHES == 1
#define PHASE_BEGIN(kind) ({ const bool run_ = (lo <= ph && ph < hi); PROBE_MARK(kind); if (run_ && ph > lo) xcd_barrier(bar); ++ph; run_; })
#else
#define PHASE_BEGIN(kind) ({ const bool run_ = (lo <= ph && ph < hi); ++ph; run_; })
#endif

    if (PHASE_BEGIN(0)) { if (ON(0)) for (int rep = 0; rep < REPS(0); ++rep) { const Frame P = phase_frame(F); mod_layer(P, 0, P.bid, P.G); } }
#pragma unroll 1
    for (int l = 0; l < DEPTH; ++l) {
        const bool odd = l & 1, last = (l == DEPTH - 1);
        const int jh = l >> 1;
        if (PHASE_BEGIN(1)) { if (ON(1)) { const Frame P = phase_frame(F); if (l == 0) { norm1_phase<0>(P, l); p0_convert(phase_frame(F)); } else norm1_phase<1>(P, l); } }
        if (PHASE_BEGIN(2)) {
            const Frame P = phase_frame(F);
            const int N = odd ? ODD_IN : EVEN_IN;
            const bf16_t* Bt = odd ? P.ODWIN() + (size_t)jh * ODD_IN * D : P.EVWIN() + (size_t)jh * EVEN_IN * D;
            EpiU E{P.U(), N, P.VT(), odd ? 1 : 0};
            if (ON(2)) for (int rep = 0; rep < REPS(2); ++rep) { pg8::DenseSched S; S.init(P.H(), D, 0, Bt, D, NTOK, N, P.G, P.bid);
                if (odd) { FEpiU FE{P.U(), N, P.VT(), 1}; pg8::gemm_phase<FEpiU, pg8::DenseSched, false, 30>(P.lds, P.tid, D, D, D, S, FE, P.ctl() + 12288 + 256 + l);
                    const int three = (NTOK / 256) * (ODD_IN / 256) - 2 * P.G;
                    if (!last && rep == 0 && P.G == 256 && P.bid >= three) convert_layer(P, l + 1, P.bid - three, P.G - three, 0, CVT_SPLIT); }
                else { FEpiUE FE{P.U()}; pg8::gemm_phase<FEpiUE, pg8::DenseSched, false, 30>(P.lds, P.tid, D, D, D, S, FE, P.ctl() + 12288 + 256 + l);
                    const int three = (NTOK / 256) * (EVEN_IN / 256) - 2 * P.G;
                    if (rep == 0 && P.G == 256 && P.bid >= three) convert_layer(P, l + 1, P.bid - three, P.G - three, 0, CVT_E1); } }
        }
        if (!odd) { if (PHASE_BEGIN(3)) { if (ON(3)) for (int rep = 0; rep < REPS(3); ++rep) { const Frame P = phase_frame(F); conv_phase(P, jh);
                if (rep == 0 && P.G == 256 && P.bid >= 64) convert_layer(P, l + 1, P.bid - 64, P.G - 64, CVT_E1, CVT_E2); } } }
        else {
            if (PHASE_BEGIN(4)) { if (ON(4)) for (int rep = 0; rep < REPS(4); ++rep) { const Frame P = phase_frame(F); attn_mix_phase(P, l); } }
            if (PHASE_BEGIN(5)) if (ON(5)) { const Frame P = phase_frame(F); pg8::DenseSched S; S.init(P.MIX(), 1024, 256, P.POOLW() + (size_t)jh * 1024 * 256, 256, last ? NLAT : NTOK, 1024, P.G, P.bid); FEpiPool FE{P.AMIX(), P.in(18) + (size_t)jh * 1024};
                pg8::gemm_phase<FEpiPool, pg8::DenseSched, false>(P.lds, P.tid, 256, 1024, 256, S, FE); }
        }
        if (PHASE_BEGIN(6)) {
            const Frame P = phase_frame(F);
            const bf16_t* Bt = odd ? P.ODWOUT() + (size_t)jh * D * D : P.EVWOUT() + (size_t)jh * D * D;
            EpiRes E{P.X(), P.MOD() + (size_t)l * 5 * MODW + 2 * D};
            if (ON(6)) { pg8::DenseSched S; S.init(P.AMIX(), D, 0, Bt, D, last ? NLAT : NTOK, D, P.G, P.bid); FEpiRes FE{P.X(), P.MOD() + (size_t)l * 5 * MODW + 2 * D};
                pg8::gemm_phase<FEpiRes, pg8::DenseSched, false, 32>(P.lds, P.tid, D, D, D, S, FE, P.ctl() + 12288 + 256 + l);
                if (!last) { const int two = (NTOK / 256) * (D / 256) - P.G;
                    const CvtPlan cp = cvt_plan(l, P.G);
                    if (two > 0 && two < P.G) { if (P.bid >= two) { convert_layer(P, l + 1, P.bid - two, P.G - two, cp.c_hi, cp.n_lo); mod_layer(phase_frame(F), l + 1, P.bid - two, P.G - two); } }
                    else { convert_layer(P, l + 1, P.bid, P.G, cp.c_hi, cp.n_lo); mod_layer(phase_frame(F), l + 1, P.bid, P.G); } } }
        }
        if (PHASE_BEGIN(7)) { if (ON(7)) { if (REPS(7) > 1) { const Frame P = phase_frame(F); norm2_router_phase(P, l, true); } const Frame P = phase_frame(F); norm2_router_phase(P, l);
            if (!last && P.G == 256 && P.bid >= 64) { const CvtPlan cp = cvt_plan(l, P.G); convert_layer(P, l + 1, P.bid - 64, P.G - 64, cp.n_lo, cp.u_lo); } } }
        if (PHASE_BEGIN(8)) { if (ON(8)) for (int rep = 0; rep < REPS(8); ++rep) { const Frame P = phase_frame(F); moe_up_fast(P, l); } }
        if (PHASE_BEGIN(9)) { if (ON(9)) for (int rep = 0; rep < REPS(9); ++rep) { const Frame P = phase_frame(F); moe_down_fast(P, l); } }
    }
    if (PHASE_BEGIN(10)) { if (ON(10)) for (int rep = 0; rep < REPS(10); ++rep) { const Frame P = phase_frame(F); norm1_phase<2>(P, DEPTH); } }
    if (PROBE_KA >= 0) { PROBE_MARK(-1); xcd_barrier(bar);
        int b2_ = F.bid; asm volatile("" : "+s"(b2_));
        if (b2_ == 0 && xb_thread0(F.wave)) { unsigned long long acc_t = 0ull;
            for (int q = 0; q < ph; ++q) { if ((int)__hip_atomic_load(F.ctl() + CW_PR + 128 + q, __ATOMIC_RELAXED, __HIP_MEMORY_SCOPE_AGENT) == PROBE_KA + 1) {
                const unsigned mx1 = __hip_atomic_load(F.ctl() + CW_PR + q + 1, __ATOMIC_RELAXED, __HIP_MEMORY_SCOPE_AGENT), mx0 = __hip_atomic_load(F.ctl() + CW_PR + q, __ATOMIC_RELAXED, __HIP_MEMORY_SCOPE_AGENT);
                const unsigned mn1 = ~__hip_atomic_load(F.ctl() + CW_PR + 64 + q + 1, __ATOMIC_RELAXED, __HIP_MEMORY_SCOPE_AGENT);
                acc_t += (PROBE_KB == 1) ? (unsigned long long)(mx1 - mn1) : (unsigned long long)(mx1 - mx0); } }
            if (PROBE_KA == 77) { acc_t = 0ull; for (int q = 0; q < DEPTH; ++q) acc_t += __hip_atomic_load(F.ctl() + 12288 + 256 + q, __ATOMIC_RELAXED, __HIP_MEMORY_SCOPE_AGENT); }
            const unsigned long long extra = (acc_t / 100ull) * 1000ull * 100ull; const unsigned long long t0 = __builtin_amdgcn_s_memrealtime();
            while (__builtin_amdgcn_s_memrealtime() - t0 < extra) __builtin_amdgcn_s_sleep(32); } }
#if TRUNC
    if (lo == 99) { const Frame P = phase_frame(F);
        for (size_t i = (size_t)P.bid * 512 + P.tid; i < (size_t)NLAT * D / 4; i += (size_t)P.G * 512) {
#if DUMP_SEL == 0
            ((f32x4*)P.out())[i] = ((const f32x4*)P.X())[i];
#elif DUMP_SEL == 1
            const u32x2 a = ((const u32x2*)P.AMIX())[i]; f32x4 v; v[0] = bf_lo(a.x); v[1] = bf_hi(a.x); v[2] = bf_lo(a.y); v[3] = bf_hi(a.y); ((f32x4*)P.out())[i] = v;
#elif DUMP_SEL == 2
            f32x4 v = {0.f, 0.f, 0.f, 0.f}; if (i < (size_t)1024 * NTOK / 4) { const u32x2 a = ((const u32x2*)P.VT())[i]; v[0] = bf_lo(a.x); v[1] = bf_hi(a.x); v[2] = bf_lo(a.y); v[3] = bf_hi(a.y); } ((f32x4*)P.out())[i] = v;
#else
            f32x4 v = {0.f, 0.f, 0.f, 0.f}; if (i < (size_t)1024 * NTOK / 4) { const u32x2 a = ((const u32x2*)P.MIX())[i]; v[0] = bf_lo(a.x); v[1] = bf_hi(a.x); v[2] = bf_lo(a.y); v[3] = bf_hi(a.y); } ((f32x4*)P.out())[i] = v;
#endif
        } }
#endif
}
constexpr int N_PHASES = 1 + (7 + 8 + 7 + 8) + 1;

extern "C" void kernel_launch(void* const* d_in, const int* in_sizes, int n_in, void* d_out, int out_size, void* d_ws, size_t ws_size, hipStream_t stream) {
    static int grid = 0;
    if (grid == 0) {
        if (n_in != 28 || in_sizes[0] != NLAT * D || out_size != NLAT * D || ws_size < WS_END) {
            fprintf(stderr, "kernel_launch: unexpected shapes (n_in %d, in0 %d, out %d, ws %zu < %zu); nothing launched\n", n_in, n_in > 0 ? in_sizes[0] : -1, out_size, ws_size, (size_t)WS_END); grid = -1; return; }
        int dev = 0, cus = 0, per_cu = 0;
        if (hipGetDevice(&dev) != hipSuccess || hipDeviceGetAttribute(&cus, hipDeviceAttributeMultiprocessorCount, dev) != hipSuccess) { grid = -1; return; }
        if (hipFuncSetAttribute((const void*)hybrid_fwd, hipFuncAttributeMaxDynamicSharedMemorySize, LDS_BYTES) != hipSuccess) { fprintf(stderr, "kernel_launch: hipFuncSetAttribute failed\n"); grid = -1; return; }
        if (hipOccupancyMaxActiveBlocksPerMultiprocessor(&per_cu, (const void*)hybrid_fwd, 512, LDS_BYTES) != hipSuccess || per_cu < 1)
            fprintf(stderr, "kernel_launch: occupancy query reports %d blocks per CU\n", per_cu);
        (void)hipGetLastError();
        grid = cus;
    }
    if (grid < 0) return;
    if (hipMemsetAsync((char*)d_ws + WS_CTL, 0, CTL_BYTES, stream) != hipSuccess) { fprintf(stderr, "kernel_launch: memset failed\n"); return; }
    Args a{};
    for (int i = 0; i < 28; ++i) a.in[i] = (const float*)d_in[i];
    a.out = (float*)d_out; a.ws = (unsigned char*)d_ws;
#if MK_N_LAUNCHES == 1
    a.ph_lo = 0; a.ph_hi = N_PHASES;
    hipLaunchKernelGGL(hybrid_fwd, dim3(grid), dim3(512), LDS_BYTES, stream, a);
#else
#if TRUNC
    for (int p = 0; p < TRUNC; ++p) { a.ph_lo = p; a.ph_hi = p + 1; hipLaunchKernelGGL(hybrid_fwd, dim3(grid), dim3(512), LDS_BYTES, stream, a); }
    a.ph_lo = 99; a.ph_hi = 100; hipLaunchKernelGGL(hybrid_fwd, dim3(grid), dim3(512), LDS_BYTES, stream, a);
#else
    for (int p = 0; p < N_PHASES; ++p) { a.ph_lo = p; a.ph_hi = p + 1; hipLaunchKernelGGL(hybrid_fwd, dim3(grid), dim3(512), LDS_BYTES, stream, a); }
#endif
#endif
    const hipError_t le = hipPeekAtLastError();
    if (le != hipSuccess) fprintf(stderr, "kernel_launch: launch failed: %s\n", hipGetErrorName(le));
}
```

```cpp
#include <hip/hip_runtime.h>
#include <cstdio>
#include <cstdint>

#ifndef TRUNC
#define TRUNC 0
#endif
#ifndef DUMP_SEL
#define DUMP_SEL 2
#endif
#ifndef DBL
#define DBL 0u
#endif
#define REPS(k) (1 + (int)(((DBL) >> (k)) & 1u))
#ifndef PROBE_KA
#define PROBE_KA -1
#define PROBE_KB -1
#endif
#ifndef NORM2_SUB
#define NORM2_SUB -1
#endif
#ifndef PHM
#define PHM 0xffffffffu
#endif
#define ON(k) (((PHM) >> (k)) & 1u)
#ifndef MK_N_LAUNCHES
#define MK_N_LAUNCHES 1
#endif

#define LAS __attribute__((address_space(3)))
typedef unsigned short bf16_t;
typedef short bf16x8 __attribute__((ext_vector_type(8)));
typedef float f32x4 __attribute__((ext_vector_type(4)));
typedef float f32x2 __attribute__((ext_vector_type(2)));
typedef unsigned u32x4 __attribute__((ext_vector_type(4)));
typedef unsigned u32x2 __attribute__((ext_vector_type(2)));

constexpr int D = 2048, NB = 4, SEQ = 2048, CTXL = 256, DEPTH = 4;
constexpr int NLAT = NB * SEQ, NCTX = NB * CTXL, NTOK = NLAT + NCTX;
constexpr int EVEN_IN = 5120, ODD_IN = 4096, MODW = 6 * D;
constexpr int NEXP = 32, FF = 256;
constexpr int UE_LD = 3072;
constexpr int SLOT_CAP = NTOK;
constexpr int HID_ROWS = 26624;

constexpr size_t al256(size_t x) { return (x + 255) & ~(size_t)255; }
constexpr size_t WS_CTL = 0, CTL_BYTES = 65536;
constexpr int CW_CNT = 8192;
constexpr size_t WS_MOD = WS_CTL + CTL_BYTES;
constexpr size_t WS_WRT = al256(WS_MOD + (size_t)DEPTH * 5 * MODW * 4);
constexpr size_t WS_TOKG = al256(WS_WRT + (size_t)DEPTH * (D / 4) * 3 * 64 * 4);
constexpr size_t WS_SLOT = al256(WS_TOKG + (size_t)NTOK * 2 * 4);
constexpr size_t WS_SLOTG = al256(WS_SLOT + (size_t)NEXP * SLOT_CAP * 4);
constexpr size_t WS_X = al256(WS_SLOTG + (size_t)NEXP * SLOT_CAP * 4);
constexpr size_t WS_H = al256(WS_X + (size_t)NTOK * D * 4);
constexpr size_t WS_U = al256(WS_H + (size_t)NTOK * D * 2);
constexpr size_t WS_VT = al256(WS_U + (size_t)NTOK * EVEN_IN * 2);
constexpr size_t WS_AMIX = al256(WS_VT + (size_t)1024 * NTOK * 2);
constexpr size_t WS_MIX = al256(WS_AMIX + (size_t)NTOK * D * 2);
constexpr size_t WS_HID = al256(WS_MIX + (size_t)NTOK * 1024 * 2);
constexpr size_t WS_Y2 = al256(WS_HID + (size_t)HID_ROWS * FF * 2);
constexpr size_t WS_EVWIN = al256(WS_Y2 + (size_t)NTOK * 2 * D * 2);
constexpr size_t WS_EVWOUT = al256(WS_EVWIN + (size_t)2 * EVEN_IN * D * 2);
constexpr size_t WS_ODWIN = al256(WS_EVWOUT + (size_t)2 * D * D * 2);
constexpr size_t WS_ODWOUT = al256(WS_ODWIN + (size_t)2 * ODD_IN * D * 2);
constexpr size_t WS_POOLW = al256(WS_ODWOUT + (size_t)2 * D * D * 2);
constexpr size_t WS_W13 = al256(WS_POOLW + (size_t)2 * 1024 * 256 * 2);
constexpr size_t WS_W2 = al256(WS_W13 + (size_t)DEPTH * NEXP * 512 * D * 2);
constexpr size_t WS_END = al256(WS_W2 + (size_t)DEPTH * NEXP * D * FF * 2);

constexpr int LDS_BYTES = 163840;
constexpr int LDS_MISC = LDS_BYTES - 256;

#define XB_TMO      128
#define XB_XCNT(j)  (256  + 64 * (j))
#define XB_XSUB(j)  (1280 + 64 * (j))
#define XB_XGEN(j)  (2304 + 64 * (j))
#define XB_TOP      3328
#define XB_TOPGEN   3392
#define XCD_BAR_WORDS 3456
#define XB_SPIN_CAP (1u << 18)

__device__ __forceinline__ unsigned xb_ld(unsigned* p)              { return __hip_atomic_load(p, __ATOMIC_RELAXED, __HIP_MEMORY_SCOPE_AGENT); }
__device__ __forceinline__ unsigned xb_add(unsigned* p, unsigned v) { return __hip_atomic_fetch_add(p, v, __ATOMIC_RELAXED, __HIP_MEMORY_SCOPE_AGENT); }
__device__ __forceinline__ unsigned xb_xcc_id() { return (unsigned)__builtin_amdgcn_s_getreg((3 << 11) | 20) & 0xFu; }
#define XB_SPIN(cond, bar) do { unsigned _sp = 0; while (cond) { __builtin_amdgcn_s_sleep(1); \
    if ((++_sp & 255u) == 0u) { if (xb_ld(&(bar)[XB_TMO])) break; if (_sp > XB_SPIN_CAP) { atomicAdd(&(bar)[XB_TMO], 1u); break; } } } } while (0)

struct XcdBarrier { unsigned* bar; unsigned x; volatile LAS unsigned* st; int wave; };
__device__ __forceinline__ bool xb_thread0(int wave) { int z = 0, w = wave; asm volatile("" : "+s"(z), "+s"(w)); return w == 0 && __builtin_amdgcn_mbcnt_hi(~0u, __builtin_amdgcn_mbcnt_lo(~0u, (unsigned)z)) == 0u; }

__device__ __forceinline__ XcdBarrier xcd_barrier_post(unsigned* bar, volatile LAS unsigned* st) {
    XcdBarrier b; b.bar = bar; b.x = xb_xcc_id(); b.st = st;
    b.wave = __builtin_amdgcn_readfirstlane((int)(threadIdx.x >> 6));
    if (threadIdx.x == 0) (void)xb_add(&bar[XB_XCNT(b.x)], 1u);
    return b;
}
__device__ __forceinline__ void xcd_barrier_complete(unsigned* bar, unsigned x, unsigned& nloc, unsigned& nx) {
    const unsigned G = gridDim.x * gridDim.y * gridDim.z;
    unsigned sum, cnt, mine, sp = 0u;
    for (;;) {
        sum = 0u; cnt = 0u; mine = 0u;
#pragma unroll
        for (unsigned j = 0; j < 16; ++j) { const unsigned c = xb_ld(&bar[XB_XCNT(j)]); sum += c; cnt += (c > 0u) ? 1u : 0u; mine = (j == x) ? c : mine; }
        if (sum == G) break;
        __builtin_amdgcn_s_sleep(1);
        if ((++sp & 255u) == 0u) { if (xb_ld(&bar[XB_TMO])) break; if (sp > XB_SPIN_CAP) { atomicAdd(&bar[XB_TMO], 1u); break; } }
    }
    nloc = mine > 0u ? mine : 1u; nx = cnt > 0u ? cnt : 1u;
}
__device__ __forceinline__ void xcd_barrier(const XcdBarrier& b) {
    asm volatile("s_waitcnt vmcnt(0)" ::: "memory");
    __syncthreads();
    if (xb_thread0(b.wave)) {
        unsigned* bar = b.bar;
        __builtin_amdgcn_s_waitcnt(0);
        unsigned nloc = b.st[0], nx = b.st[1];
        if (nloc == 0u) { xcd_barrier_complete(bar, xb_xcc_id(), nloc, nx); b.st[0] = nloc; b.st[1] = nx; }
        const unsigned old = xb_add(&bar[XB_XSUB(b.x)], 1u);
        const unsigned gen = old / nloc;
        if (old + 1u == (gen + 1u) * nloc) {
            __builtin_amdgcn_fence(__ATOMIC_RELEASE, "agent");
            asm volatile("s_waitcnt vmcnt(0)" ::: "memory");
            const unsigned og = xb_add(&bar[XB_TOP], 1u);
            const unsigned tg = og / nx;
            if (og + 1u == (tg + 1u) * nx) xb_add(&bar[XB_TOPGEN], 1u);
            else XB_SPIN(xb_ld(&bar[XB_TOPGEN]) == tg, bar);
            __builtin_amdgcn_fence(__ATOMIC_ACQUIRE, "agent");
            xb_add(&bar[XB_XGEN(b.x)], 1u);
            asm volatile("s_waitcnt vmcnt(0)" ::: "memory");
        } else {
            XB_SPIN(xb_ld(&bar[XB_XGEN(b.x)]) == gen, bar);
            __builtin_amdgcn_fence(__ATOMIC_ACQUIRE, "agent");
            asm volatile("s_waitcnt vmcnt(0)" ::: "memory");
        }
    }
    __syncthreads();
}

typedef __bf16 bf16v2_t __attribute__((ext_vector_type(2)));
__device__ __forceinline__ unsigned cvt_pk_bf16(float lo, float hi) { const f32x2 v = {lo, hi}; const bf16v2_t r = __builtin_convertvector(v, bf16v2_t); return __builtin_bit_cast(unsigned, r); }
__device__ __forceinline__ float bf_lo(unsigned u) { return __uint_as_float(u << 16); }
__device__ __forceinline__ float bf_hi(unsigned u) { return __uint_as_float(u & 0xffff0000u); }
__device__ __forceinline__ float shfl_x(float v, int o, int lane) { return __builtin_bit_cast(float, __builtin_amdgcn_ds_bpermute((lane ^ o) << 2, __builtin_bit_cast(int, v))); }
template <int CTRL> __device__ __forceinline__ float dpp_f(float v) { return __builtin_bit_cast(float, __builtin_amdgcn_update_dpp(0, __builtin_bit_cast(int, v), CTRL, 0xF, 0xF, true)); }
__device__ __forceinline__ float wave_sum(float v, int) {
    v += dpp_f<0xB1>(v); v += dpp_f<0x4E>(v); v += dpp_f<0x141>(v); v += dpp_f<0x140>(v);
    const int iv = __builtin_bit_cast(int, v);
    return (__builtin_bit_cast(float, __builtin_amdgcn_readlane(iv, 0)) + __builtin_bit_cast(float, __builtin_amdgcn_readlane(iv, 16))) +
           (__builtin_bit_cast(float, __builtin_amdgcn_readlane(iv, 32)) + __builtin_bit_cast(float, __builtin_amdgcn_readlane(iv, 48)));
}
__device__ __forceinline__ float sigmoidf_(float x) { return __builtin_amdgcn_rcpf(1.0f + __builtin_amdgcn_exp2f(-1.4426950408889634f * x)); }
__device__ __forceinline__ float siluf_(float x) { return x * __builtin_amdgcn_rcpf(1.0f + __builtin_amdgcn_exp2f(-1.4426950408889634f * x)); }

struct Args { const float* in[28]; float* out; unsigned char* ws; int ph_lo, ph_hi; };
#define CAS __attribute__((address_space(4)))
struct Frame {
    LAS unsigned char* lds; int tid, lane, wave; int G, bid;
    const CAS Args* ka;
    __device__ __forceinline__ const float* in(int i) const { return ka->in[i]; }
    __device__ __forceinline__ unsigned char* ws() const { return ka->ws; }
    __device__ __forceinline__ float* out() const { return ka->out; }
    __device__ __forceinline__ unsigned* ctl() const { return (unsigned*)(ws() + WS_CTL); }
    __device__ __forceinline__ float* MOD() const { return (float*)(ws() + WS_MOD); }
    __device__ __forceinline__ float* WRT() const { return (float*)(ws() + WS_WRT); }
    __device__ __forceinline__ float* TOKG() const { return (float*)(ws() + WS_TOKG); }
    __device__ __forceinline__ int* SLOT() const { return (int*)(ws() + WS_SLOT); }
    __device__ __forceinline__ float* SLOTG() const { return (float*)(ws() + WS_SLOTG); }
    __device__ __forceinline__ float* X() const { return (float*)(ws() + WS_X); }
    __device__ __forceinline__ bf16_t* H() const { return (bf16_t*)(ws() + WS_H); }
    __device__ __forceinline__ bf16_t* U() const { return (bf16_t*)(ws() + WS_U); }
    __device__ __forceinline__ bf16_t* VT() const { return (bf16_t*)(ws() + WS_VT); }
    __device__ __forceinline__ bf16_t* AMIX() const { return (bf16_t*)(ws() + WS_AMIX); }
    __device__ __forceinline__ bf16_t* MIX() const { return (bf16_t*)(ws() + WS_MIX); }
    __device__ __forceinline__ bf16_t* HID() const { return (bf16_t*)(ws() + WS_HID); }
    __device__ __forceinline__ bf16_t* Y2() const { return (bf16_t*)(ws() + WS_Y2); }
    __device__ __forceinline__ bf16_t* EVWIN() const { return (bf16_t*)(ws() + WS_EVWIN); }
    __device__ __forceinline__ bf16_t* EVWOUT() const { return (bf16_t*)(ws() + WS_EVWOUT); }
    __device__ __forceinline__ bf16_t* ODWIN() const { return (bf16_t*)(ws() + WS_ODWIN); }
    __device__ __forceinline__ bf16_t* ODWOUT() const { return (bf16_t*)(ws() + WS_ODWOUT); }
    __device__ __forceinline__ bf16_t* POOLW() const { return (bf16_t*)(ws() + WS_POOLW); }
    __device__ __forceinline__ bf16_t* W13() const { return (bf16_t*)(ws() + WS_W13); }
    __device__ __forceinline__ bf16_t* W2() const { return (bf16_t*)(ws() + WS_W2); }
};

__device__ __forceinline__ Frame phase_frame(const Frame& F0) {
    Frame F = F0;
    int z = 0; asm volatile("" : "+s"(z));
    const int lane = (int)__builtin_amdgcn_mbcnt_hi(~0u, __builtin_amdgcn_mbcnt_lo(~0u, (unsigned)z));
    int w = F0.wave; asm volatile("" : "+s"(w));
    F.lane = lane; F.wave = w; F.tid = w * 64 + lane;
    unsigned long long k = (unsigned long long)F0.ka; asm volatile("" : "+s"(k)); F.ka = (const CAS Args*)k;
    int b = F0.bid; asm volatile("" : "+s"(b)); F.bid = b;
    return F;
}

struct CvtTile { const float* src; bf16_t* dst; int N, K; };
__device__ __forceinline__ int cvt_layer_tiles(int L) { return (L & 1) ? (32 * 32 + 32 * 16 + 4 * 4 * 2 + 3 * 32 * 32 * 2) : (32 * 40 + 32 * 16 + 3 * 32 * 32 * 2); }
__device__ __forceinline__ void cvt_desc(const Frame& F, int L, int t, CvtTile& d) {
    const int j = L >> 1, odd = L & 1;
    const int A0 = odd ? 32 * 32 : 32 * 40, A1 = A0 + 32 * 16, A2 = A1 + (odd ? 32 : 0), A3 = A2 + 2048, A4 = A3 + 2048;
    const float* src; bf16_t* dst; int K, N, ro = 0, w13 = 0, evin = 0; size_t dstb = 0; int r;
    if (t < A0)      { r = t;      evin = !odd; K = D; N = odd ? ODD_IN : EVEN_IN; src = (odd ? F.in(15) : F.in(8)) + (size_t)j * K * N; dst = (odd ? F.ODWIN() : F.EVWIN()) + (size_t)j * N * K; }
    else if (t < A1) { r = t - A0; K = D; N = D; src = (odd ? F.in(19) : F.in(14)) + (size_t)j * K * N; dst = (odd ? F.ODWOUT() : F.EVWOUT()) + (size_t)j * N * K; }
    else if (t < A2) { r = t - A1; K = 256; N = 256; src = F.in(17) + (size_t)j * 4 * 256 * 256; dst = F.POOLW() + (size_t)j * 1024 * 256; dstb = (size_t)256 * 256; }
    else if (t < A3) { r = t - A2; K = D; N = FF; src = F.in(24) + (size_t)L * NEXP * D * FF; dst = F.W13() + (size_t)L * NEXP * 512 * D; dstb = (size_t)512 * D; w13 = 1; }
    else if (t < A4) { r = t - A3; K = D; N = FF; src = F.in(25) + (size_t)L * NEXP * D * FF; dst = F.W13() + (size_t)L * NEXP * 512 * D; dstb = (size_t)512 * D; w13 = 1; ro = 128; }
    else             { r = t - A4; K = FF; N = D; src = F.in(26) + (size_t)L * NEXP * FF * D; dst = F.W2() + (size_t)L * NEXP * D * FF; dstb = (size_t)D * FF; }
    const int tk = K / 64, tn = N / 128, per = tk * tn, b = r / per, rem = r - b * per, k0 = (rem / tn) * 64, n0 = (rem % tn) * 128;
    int drow = w13 ? (n0 / 128) * 256 + ro : n0;
    if (evin && n0 >= 1024) { const int grp = n0 >> 10, kq = (n0 & 1023) >> 7;
        drow = (grp <= 2 ? 1024 : 3072) + 256 * kq + ((grp == 2 || grp == 4) ? 128 : 0); }
    d.src = src + (size_t)b * K * N + (size_t)k0 * N + n0; d.dst = dst + (size_t)b * dstb + (size_t)drow * K + k0; d.N = N; d.K = K;
}
constexpr int CVT_MOE = 3 * 2048;
__device__ __forceinline__ int cvt_head_tiles(int L) { return (L & 1) ? (32 * 32 + 32 * 16 + 4 * 4 * 2) : (32 * 40 + 32 * 16); }
__device__ __forceinline__ int cvt_stream_tiles(int l) { return (l >= 0 ? CVT_MOE : 0) + (l + 1 < DEPTH ? cvt_head_tiles(l + 1) : 0); }
__device__ __forceinline__ void cvt_stream_desc(const Frame& F, int l, int t, CvtTile& d) {
    const int moe = l >= 0 ? CVT_MOE : 0;
    if (t < moe) cvt_desc(F, l, cvt_head_tiles(l) + t, d); else cvt_desc(F, l + 1, t - moe, d);
}
constexpr int CVT_SPLIT = 3456 + 1120, CVT_E1 = 864 + 240, CVT_E2 = CVT_E1 + 1536, CVT_UP = 1872;
__device__ __forceinline__ void convert_layer(const Frame& F, int L, int first, int stride, int t_lo = 0, int t_hi = 1 << 30) {
    constexpr int LD = 129;
    LAS float* T = (LAS float*)F.lds;
    const int tid = F.tid, ntile = cvt_stream_tiles(L) < t_hi ? cvt_stream_tiles(L) : t_hi;
    const int lk = tid >> 5, lc = (tid & 31) * 4;
    const int sn = tid >> 2, sk = (tid & 3) * 16;
    f32x4 v[2][4]; CvtTile d[2];
    int t = t_lo + first;
#pragma unroll
    for (int q = 0; q < 2; ++q) { const int tq = t + q * stride; d[q].src = nullptr; d[q].dst = nullptr; d[q].N = 0; d[q].K = 0;
        if (tq < ntile) { cvt_stream_desc(F, L, tq, d[q]);
#pragma unroll
            for (int p = 0; p < 4; ++p) v[q][p] = __builtin_nontemporal_load((const f32x4*)(d[q].src + (size_t)(lk + 16 * p) * d[q].N + lc)); } }
#pragma unroll 1
    for (; t < ntile; t += 2 * stride) {
#pragma unroll
        for (int q = 0; q < 2; ++q) {
            const int tq = t + q * stride;
            if (tq < ntile) {
                LAS float* Tb = T + q * (64 * LD);
#pragma unroll
                for (int p = 0; p < 4; ++p) { LAS float* w = Tb + (lk + 16 * p) * LD + lc; w[0] = v[q][p][0]; w[1] = v[q][p][1]; w[2] = v[q][p][2]; w[3] = v[q][p][3]; }
                __syncthreads();
                bf16_t* dp = d[q].dst + (size_t)sn * d[q].K + sk;
                const int tn = tq + 2 * stride;
                if (tn < ntile) { cvt_stream_desc(F, L, tn, d[q]);
#pragma unroll
                    for (int p = 0; p < 4; ++p) v[q][p] = __builtin_nontemporal_load((const f32x4*)(d[q].src + (size_t)(lk + 16 * p) * d[q].N + lc)); }
                float x[16];
#pragma unroll
                for (int e = 0; e < 16; ++e) x[e] = Tb[(sk + e) * LD + sn];
                u32x4 w0, w1;
                w0.x = cvt_pk_bf16(x[0], x[1]); w0.y = cvt_pk_bf16(x[2], x[3]); w0.z = cvt_pk_bf16(x[4], x[5]); w0.w = cvt_pk_bf16(x[6], x[7]);
                w1.x = cvt_pk_bf16(x[8], x[9]); w1.y = cvt_pk_bf16(x[10], x[11]); w1.z = cvt_pk_bf16(x[12], x[13]); w1.w = cvt_pk_bf16(x[14], x[15]);
                *(u32x4*)dp = w0; *(u32x4*)(dp + 8) = w1;
            }
        }
    }
    __syncthreads();
}
struct CvtPlan { int i_hi, c_hi, n_lo, u_lo, nt; };
__device__ __forceinline__ CvtPlan cvt_plan(int l, int G) {
    CvtPlan p; p.nt = cvt_stream_tiles(l);
    if (G != 256) { p.i_hi = 0; p.c_hi = 0; p.n_lo = p.nt; p.u_lo = p.nt; return p; }
    if (l & 1) { p.i_hi = CVT_SPLIT; p.c_hi = CVT_SPLIT; } else { p.i_hi = CVT_E1; p.c_hi = CVT_E2; }
    p.u_lo = p.nt - CVT_UP; if (p.u_lo < p.c_hi) p.u_lo = p.c_hi; p.n_lo = (l == DEPTH - 1) ? p.u_lo : p.u_lo - 960; return p;
}
__device__ __forceinline__ void p0_convert(const Frame& F) {
    convert_layer(F, -1, F.bid, F.G);
    const int tid = F.tid;
    for (int i = F.bid * 512 + tid; i < DEPTH * 64 * 3 * 64; i += F.G * 512) {
        const int ln = i & 63, nt = (i >> 6) % 3, s = (i / 192) & 63, l = i / (192 * 64);
        const int c = 16 * nt + (ln & 15), k0 = 32 * s + 8 * (ln >> 4);
        float wv[8];
#pragma unroll
        for (int e = 0; e < 8; ++e) wv[e] = (c < 4) ? F.in(20)[((size_t)l * D + k0 + e) * 4 + c] : (c < 36 ? F.in(22)[((size_t)l * D + k0 + e) * 32 + (c - 4)] : 0.f);
        u32x4 hi, lo;
#pragma unroll
        for (int q = 0; q < 4; ++q) {
            const unsigned hp = cvt_pk_bf16(wv[2 * q], wv[2 * q + 1]);
            const unsigned lp = cvt_pk_bf16(wv[2 * q] - bf_lo(hp), wv[2 * q + 1] - bf_hi(hp));
            hi[q] = hp; lo[q] = lp;
        }
        u32x4* dst = (u32x4*)F.WRT() + ((size_t)(l * 64 + s) * 3 + nt) * 128 + ln;
        dst[0] = hi; dst[64] = lo;
    }
}

__device__ __forceinline__ void mod_layer(const Frame& F, int L, int first, int stride) {
    LAS float* sc = (LAS float*)F.lds;
    LAS float* red = sc + 5 * D;
    for (int i = F.tid; i < 5 * D; i += 512) { const float c = (i < 4 * D) ? F.in(1)[i] : F.in(3)[i - 4 * D]; sc[i] = siluf_(c); }
    __syncthreads();
    const int kq = F.lane >> 4, c4 = (F.lane & 15) * 4;
#pragma unroll 1
    for (int u = first; u < 192; u += stride) {
        const int l = L, n0 = u * 64;
        const float* W = F.in(4) + (size_t)l * D * MODW + n0 + c4;
        f32x4 acc[5];
#pragma unroll
        for (int s = 0; s < 5; ++s) acc[s] = (f32x4){0.f, 0.f, 0.f, 0.f};
#pragma unroll 8
        for (int it = 0; it < 64; ++it) {
            const int k = it * 32 + F.wave * 4 + kq;
            const f32x4 w = *(const f32x4*)(W + (size_t)k * MODW);
#pragma unroll
            for (int s = 0; s < 5; ++s) acc[s] += sc[s * D + k] * w;
        }
#pragma unroll
        for (int s = 0; s < 5; ++s)
#pragma unroll
            for (int i = 0; i < 4; ++i) { float v = acc[s][i]; v += shfl_x(v, 16, F.lane); v += shfl_x(v, 32, F.lane); acc[s][i] = v; }
        if (kq == 0) {
#pragma unroll
            for (int s = 0; s < 5; ++s)
#pragma unroll
                for (int i = 0; i < 4; ++i) red[(F.wave * 5 + s) * 64 + c4 + i] = acc[s][i];
        }
        __syncthreads();
        if (F.tid < 320) { const int s = F.tid >> 6, col = F.tid & 63; float v = F.in(5)[(size_t)l * MODW + n0 + col];
#pragma unroll
            for (int w = 0; w < 8; ++w) v += red[(w * 5 + s) * 64 + col];
            F.MOD()[((size_t)l * 5 + s) * MODW + n0 + col] = v; }
        __syncthreads();
    }
}

template <int MODE>
__device__ __forceinline__ void norm1_phase(const Frame& F, int l) {
    const int nrows = (MODE == 2) ? NLAT : NTOK;
    const float* g = (MODE == 2) ? F.in(27) : F.in(6) + (size_t)l * D;
#pragma unroll 1
    for (int r = F.bid * 8 + F.wave; r < nrows; r += F.G * 8) {
        const int s = r < NLAT ? r / SEQ : 4;
        f32x4 v[8];
        if (MODE == 0) {
            const float* src = r < NLAT ? F.in(0) + (size_t)r * D : F.in(2) + (size_t)(r - NLAT) * D;
#pragma unroll
            for (int j = 0; j < 8; ++j) v[j] = *(const f32x4*)(src + j * 256 + F.lane * 4);
        } else {
            const float* xr = F.X() + (size_t)r * D;
            const float* g5 = F.MOD() + ((size_t)(l - 1) * 5 + s) * MODW + 5 * D;
            const bf16_t* y = F.Y2() + (size_t)r * 2 * D;
#pragma unroll
            for (int j = 0; j < 8; ++j) {
                const int idx = j * 256 + F.lane * 4;
                const f32x4 x = *(const f32x4*)(xr + idx), gg = *(const f32x4*)(g5 + idx);
                const u32x2 a = *(const u32x2*)(y + idx), b = *(const u32x2*)(y + D + idx);
                f32x4 ys; ys[0] = bf_lo(a.x) + bf_lo(b.x); ys[1] = bf_hi(a.x) + bf_hi(b.x); ys[2] = bf_lo(a.y) + bf_lo(b.y); ys[3] = bf_hi(a.y) + bf_hi(b.y);
                v[j] = x + gg * ys;
            }
        }
        float ss = 0.f;
#pragma unroll
        for (int j = 0; j < 8; ++j) ss += v[j][0] * v[j][0] + v[j][1] * v[j][1] + v[j][2] * v[j][2] + v[j][3] * v[j][3];
        ss = wave_sum(ss, F.lane);
        const float rstd = rsqrtf(ss * (1.0f / D) + 1e-6f);
        if (MODE == 2) {
            float* o = F.out() + (size_t)r * D;
#pragma unroll
            for (int j = 0; j < 8; ++j) { const int idx = j * 256 + F.lane * 4; *(f32x4*)(o + idx) = v[j] * rstd * *(const f32x4*)(g + idx); }
        } else {
            float* xr = F.X() + (size_t)r * D;
            const float* sh = F.MOD() + ((size_t)l * 5 + s) * MODW;
            const float* scl = sh + D;
            bf16_t* h = F.H() + (size_t)r * D;
#pragma unroll
            for (int j = 0; j < 8; ++j) {
                const int idx = j * 256 + F.lane * 4;
                *(f32x4*)(xr + idx) = v[j];
                const f32x4 hv = v[j] * rstd * *(const f32x4*)(g + idx) * (1.0f + *(const f32x4*)(scl + idx)) + *(const f32x4*)(sh + idx);
                u32x2 w; w.x = cvt_pk_bf16(hv[0], hv[1]); w.y = cvt_pk_bf16(hv[2], hv[3]);
                *(u32x2*)(h + idx) = w;
            }
        }
    }
}

__device__ __forceinline__ void norm2_router_phase(const Frame& F, int l, bool dry = false) {
    constexpr int RSB = 2056;
    const int nrows = (l == DEPTH - 1) ? NLAT : NTOK;
    LAS bf16_t* hh = (LAS bf16_t*)F.lds;
    LAS bf16_t* hl = hh + 16 * RSB;
    LAS float* part = (LAS float*)(F.lds + 2 * 16 * RSB * 2);
    const float* g2 = F.in(7) + (size_t)l * D;
    const u32x4* wb = (const u32x4*)F.WRT() + (size_t)l * 64 * 3 * 128;
    unsigned* cnt = F.ctl() + CW_CNT + l * 32;
    const int w = F.wave, lane = F.lane;
    LAS int* selp = (LAS int*)(part + 8 * 768 + 16 * 40);
    int nstep = 0;
#pragma unroll 1
    for (int it = F.bid; it < nrows / 16; it += F.G) {
        const int r0 = it * 16;
        const int s = r0 < NLAT ? r0 / SEQ : 4;
        const float* sh = F.MOD() + ((size_t)l * 5 + s) * MODW + 3 * D;
        const float* scl = sh + D;
        {
            f32x4 v[2][8]; float ss[2];
#pragma unroll
            for (int rr = 0; rr < 2; ++rr) { const float* xr = F.X() + (size_t)(r0 + 2 * w + rr) * D;
#pragma unroll
                for (int j = 0; j < 8; ++j) v[rr][j] = *(const f32x4*)(xr + j * 256 + lane * 4); }
#pragma unroll
            for (int rr = 0; rr < 2; ++rr) { float a = 0.f;
#pragma unroll
                for (int j = 0; j < 8; ++j) a += v[rr][j][0] * v[rr][j][0] + v[rr][j][1] * v[rr][j][1] + v[rr][j][2] * v[rr][j][2] + v[rr][j][3] * v[rr][j][3];
                ss[rr] = rsqrtf(wave_sum(a, lane) * (1.0f / D) + 1e-6f); }
#pragma unroll
            for (int j = 0; j < 8; ++j) {
                const int idx = j * 256 + lane * 4;
                const f32x4 gs = *(const f32x4*)(g2 + idx) * (1.0f + *(const f32x4*)(scl + idx)), shv = *(const f32x4*)(sh + idx);
#pragma unroll
                for (int rr = 0; rr < 2; ++rr) {
                    const int lr = 2 * w + rr;
                    const f32x4 hv = v[rr][j] * ss[rr] * gs + shv;
                    u32x2 ph, pl; ph.x = cvt_pk_bf16(hv[0], hv[1]); ph.y = cvt_pk_bf16(hv[2], hv[3]);
                    pl.x = cvt_pk_bf16(hv[0] - bf_lo(ph.x), hv[1] - bf_hi(ph.x)); pl.y = cvt_pk_bf16(hv[2] - bf_lo(ph.y), hv[3] - bf_hi(ph.y));
                    *(u32x2*)(F.H() + (size_t)(r0 + lr) * D + idx) = ph;
                    *(LAS u32x2*)(hh + lr * RSB + idx) = ph; *(LAS u32x2*)(hl + lr * RSB + idx) = pl;
                }
            }
        }
        __syncthreads();
        f32x4 acc[3];
#pragma unroll
        for (int nt = 0; nt < 3; ++nt) acc[nt] = (f32x4){0.f, 0.f, 0.f, 0.f};
        {
            const LAS bf16_t* ah = hh + (lane & 15) * RSB + 256 * w + 8 * (lane >> 4);
            const LAS bf16_t* al = hl + (lane & 15) * RSB + 256 * w + 8 * (lane >> 4);
            const u32x4* bp = wb + (size_t)(8 * w) * 3 * 128 + lane;
            u32x4 wq[2][3][2];
#pragma unroll
            for (int st = 0; st < 2; ++st)
#pragma unroll
                for (int nt = 0; nt < 3; ++nt) { wq[st][nt][0] = bp[(size_t)(st * 3 + nt) * 128]; wq[st][nt][1] = bp[(size_t)(st * 3 + nt) * 128 + 64]; }
#pragma unroll
            for (int ks = 0; ks < 8; ++ks) {
                const bf16x8 xh = *(const LAS bf16x8*)(ah + 32 * ks), xl = *(const LAS bf16x8*)(al + 32 * ks);
#pragma unroll
                for (int nt = 0; nt < 3; ++nt) {
                    const bf16x8 wh = __builtin_bit_cast(bf16x8, wq[ks % 2][nt][0]), wl = __builtin_bit_cast(bf16x8, wq[ks % 2][nt][1]);
                    if (ks + 2 < 8) { wq[ks % 2][nt][0] = bp[(size_t)((ks + 2) * 3 + nt) * 128]; wq[ks % 2][nt][1] = bp[(size_t)((ks + 2) * 3 + nt) * 128 + 64]; }
                    acc[nt] = __builtin_amdgcn_mfma_f32_16x16x32_bf16(wh, xh, acc[nt], 0, 0, 0);
                    acc[nt] = __builtin_amdgcn_mfma_f32_16x16x32_bf16(wl, xh, acc[nt], 0, 0, 0);
                    acc[nt] = __builtin_amdgcn_mfma_f32_16x16x32_bf16(wh, xl, acc[nt], 0, 0, 0);
                }
            }
        }
#pragma unroll
        for (int nt = 0; nt < 3; ++nt) *(LAS f32x4*)(part + (w * 16 + (lane & 15)) * 48 + nt * 16 + 4 * (lane >> 4)) = acc[nt];
        __syncthreads();
        LAS float* lgt = part + 8 * 768;
        { const int rr = F.tid >> 5, cc = F.tid & 31; float a0 = 0.f, a1 = 0.f;
#pragma unroll
          for (int ww = 0; ww < 8; ++ww) { a0 += part[ww * 768 + rr * 48 + cc]; if (cc < 4) a1 += part[ww * 768 + rr * 48 + 32 + cc]; }
          lgt[rr * 40 + cc] = a0; if (cc < 4) lgt[rr * 40 + 32 + cc] = a1; }
        __syncthreads();
        if (F.tid < 16 && !dry) {
            const int r = r0 + F.tid;
            const LAS float* L = lgt + F.tid * 40;
            float gl[4]; float gm = -3.0e38f; int gi = 0;
#pragma unroll
            for (int q = 0; q < 4; ++q) { const float sacc = F.in(21)[l * 4 + q] + L[q]; gl[q] = sacc; if (sacc > gm) { gm = sacc; gi = q; } }
            float gs = 0.f;
#pragma unroll
            for (int q = 0; q < 4; ++q) gs += __expf(gl[q] - gm);
            const float gp = 1.0f / gs;
            float el[8]; float m1 = -3.0e38f; int i1 = 0;
#pragma unroll
            for (int q = 0; q < 8; ++q) { const float sacc = F.in(23)[l * 32 + gi * 8 + q] + L[4 + gi * 8 + q]; el[q] = sacc; if (sacc > m1) { m1 = sacc; i1 = q; } }
            float m2 = -3.0e38f; int i2 = 0;
#pragma unroll
            for (int q = 0; q < 8; ++q) { if (q != i1 && el[q] > m2) { m2 = el[q]; i2 = q; } }
            const float e2 = __expf(m2 - m1);
            const float w1 = gp / (1.0f + e2), w2 = gp * e2 / (1.0f + e2);
            const int ex1 = gi * 8 + i1, ex2 = gi * 8 + i2;
            (void)r;
            LAS int* sp = selp + (nstep * 16 + F.tid) * 4;
            sp[0] = ex1; sp[1] = ex2; sp[2] = __float_as_int(w1); sp[3] = __float_as_int(w2);
        }
        ++nstep;
        __syncthreads();
    }
    if (!dry) {
        const int nsel = nstep * 16;
        LAS int* hist = selp + nsel * 4; LAS int* base = hist + 32;
        if (F.tid < 32) hist[F.tid] = 0;
        __syncthreads();
        int rk1 = 0, rk2 = 0, e1 = 0, e2 = 0;
        if (F.tid < nsel) { e1 = selp[F.tid * 4]; e2 = selp[F.tid * 4 + 1]; rk1 = __hip_atomic_fetch_add(hist + e1, 1, __ATOMIC_RELAXED, __HIP_MEMORY_SCOPE_WORKGROUP); rk2 = __hip_atomic_fetch_add(hist + e2, 1, __ATOMIC_RELAXED, __HIP_MEMORY_SCOPE_WORKGROUP); }
        __syncthreads();
        if (F.tid < 32) { const int c = hist[F.tid]; base[F.tid] = c > 0 ? (int)atomicAdd(cnt + F.tid, (unsigned)c) : 0; }
        __syncthreads();
        if (F.tid < nsel) {
            const int r = (F.bid + (F.tid >> 4) * F.G) * 16 + (F.tid & 15);
            const int p1 = base[e1] + rk1, p2 = base[e2] + rk2;
            F.SLOT()[(size_t)e1 * SLOT_CAP + p1] = r * 2; F.SLOT()[(size_t)e2 * SLOT_CAP + p2] = r * 2 + 1;
            F.SLOTG()[(size_t)e1 * SLOT_CAP + p1] = __int_as_float(selp[F.tid * 4 + 2]); F.SLOTG()[(size_t)e2 * SLOT_CAP + p2] = __int_as_float(selp[F.tid * 4 + 3]);
        }
        __syncthreads();
    }
}

__device__ __forceinline__ void sgemm_core(const bf16_t* (&ap)[4], const bf16_t* bp0, const bf16_t* bp1, int K, f32x4 (&a)[4], f32x4 (&b)[4]) {
#pragma unroll
    for (int m = 0; m < 4; ++m) { a[m] = (f32x4){0.f, 0.f, 0.f, 0.f}; b[m] = (f32x4){0.f, 0.f, 0.f, 0.f}; }
#pragma unroll 2
    for (int k0 = 0; k0 < K; k0 += 32) {
        const bf16x8 b0 = *(const bf16x8*)(bp0 + k0), b1 = *(const bf16x8*)(bp1 + k0);
        bf16x8 af[4];
#pragma unroll
        for (int m = 0; m < 4; ++m) af[m] = *(const bf16x8*)(ap[m] + k0);
#pragma unroll
        for (int m = 0; m < 4; ++m) { a[m] = __builtin_amdgcn_mfma_f32_16x16x32_bf16(b0, af[m], a[m], 0, 0, 0); b[m] = __builtin_amdgcn_mfma_f32_16x16x32_bf16(b1, af[m], b[m], 0, 0, 0); }
    }
}

template <class Epi>
__device__ __forceinline__ void sgemm_phase(const Frame& F, const bf16_t* A, int lda, int a_pn_off, const bf16_t* Bt, int ldb, int M, int N, int K, const Epi& E) {
    const int fr = F.lane & 15, fq = F.lane >> 4;
    const int nM = M / 64, nN = N / 256, total = nM * nN;
#pragma unroll 1
    for (int u = F.bid; u < total; u += F.G) {
        const int pm = u / nN, pn = u % nN;
        const bf16_t* ap[4];
#pragma unroll
        for (int m = 0; m < 4; ++m) ap[m] = A + (size_t)(pm * 64 + m * 16 + fr) * lda + pn * a_pn_off + 8 * fq;
        const bf16_t* bp0 = Bt + (size_t)(pn * 256 + F.wave * 16 + fr) * ldb + 8 * fq;
        const bf16_t* bp1 = bp0 + (size_t)128 * ldb;
        f32x4 a[4], b[4];
        sgemm_core(ap, bp0, bp1, K, a, b);
#pragma unroll
        for (int m = 0; m < 4; ++m) E(pm * 64 + m * 16 + fr, pn * 256 + F.wave * 16 + 4 * fq, a[m], b[m]);
    }
}

__device__ __forceinline__ void st_bf16x4(bf16_t* p, f32x4 v) { u32x2 w; w.x = cvt_pk_bf16(v[0], v[1]); w.y = cvt_pk_bf16(v[2], v[3]); *(u32x2*)p = w; }

struct EpiU {
    bf16_t* U; int ldu; bf16_t* VT; int odd;
    __device__ __forceinline__ void operator()(int row, int col, f32x4 a, f32x4 b) const {
        st_bf16x4(U + (size_t)row * ldu + col, a); st_bf16x4(U + (size_t)row * ldu + col + 128, b);
        if (odd && col >= 2048 && col < 3072) {
#pragma unroll
            for (int i = 0; i < 4; ++i) {
                VT[(size_t)(col - 2048 + i) * NTOK + row] = (bf16_t)(cvt_pk_bf16(a[i], 0.f) & 0xffffu);
                VT[(size_t)(col - 2048 + 128 + i) * NTOK + row] = (bf16_t)(cvt_pk_bf16(b[i], 0.f) & 0xffffu);
            }
        }
    }
};
struct EpiPool {
    bf16_t* AMIX; const float* scale;
    __device__ __forceinline__ void operator()(int row, int col, f32x4 a, f32x4 b) const {
        st_bf16x4(AMIX + (size_t)row * D + 1024 + col, a * *(const f32x4*)(scale + col));
        st_bf16x4(AMIX + (size_t)row * D + 1024 + col + 128, b * *(const f32x4*)(scale + col + 128));
    }
};
struct EpiRes {
    float* X; const float* MODl;
    __device__ __forceinline__ void operator()(int row, int col, f32x4 a, f32x4 b) const {
        const int s = row < NLAT ? row / SEQ : 4;
        const float* g = MODl + (size_t)s * MODW;
        float* x = X + (size_t)row * D + col;
        *(f32x4*)x = *(const f32x4*)x + *(const f32x4*)(g + col) * a;
        *(f32x4*)(x + 128) = *(const f32x4*)(x + 128) + *(const f32x4*)(g + col + 128) * b;
    }
};

__device__ __forceinline__ void conv_phase(const Frame& F, int je) {
    LAS float* part = (LAS float*)F.lds;
    const int ch = 2 * F.tid;
    const float* cw = F.in(9) + (size_t)je * 3 * 1024;
    const float* dw = F.in(10) + (size_t)je * 31 * 1024 + ch;
    const f32x2 dwb = *(const f32x2*)(F.in(11) + (size_t)je * 1024 + ch);
    const f32x2 lng = *(const f32x2*)(F.in(12) + (size_t)je * 1024 + ch);
    const f32x2 lnb = *(const f32x2*)(F.in(13) + (size_t)je * 1024 + ch);
    const f32x2 ca0 = *(const f32x2*)(cw + ch), ca1 = *(const f32x2*)(cw + 1024 + ch), ca2 = *(const f32x2*)(cw + 2048 + ch);
    constexpr int UL = NLAT / 16, UC = NCTX / 16;
    int it = 0;
    unsigned long long cv_acc = 0ull, cv_prev = 0ull;
#define CV_STAMP(k) do { if (NORM2_SUB >= 40 && NORM2_SUB < 50) { const unsigned long long t_ = __builtin_amdgcn_s_memrealtime(); if (NORM2_SUB == (k)) cv_acc += t_ - cv_prev; cv_prev = t_; } } while (0)
#pragma unroll 1
    for (int u = F.bid; u < UL + UC; u += F.G, ++it) {
        int srow0, L, t0;
        if (u < UL) { const int b = u / (SEQ / 16); srow0 = b * SEQ; L = SEQ; t0 = (u % (SEQ / 16)) * 16; }
        else { const int v = u - UL, b = v / (CTXL / 16); srow0 = NLAT + b * CTXL; L = CTXL; t0 = (v % (CTXL / 16)) * 16; }
        CV_STAMP(99);
        const bf16_t* Ub = F.U() + (size_t)srow0 * UE_LD + ch;
        f32x2 z[46];
        {
            unsigned zz[46];
#pragma unroll
            for (int q = 0; q < 46; ++q) { const int t = t0 - 15 + q; zz[q] = (t >= 0 && t < L) ? *(const unsigned*)(Ub + (size_t)t * UE_LD + 2048) : 0u; }
#pragma unroll
            for (int q = 0; q < 46; ++q) { z[q].x = bf_lo(zz[q]); z[q].y = bf_hi(zz[q]); }
        }
        asm volatile("s_waitcnt vmcnt(0)" ::: "memory"); CV_STAMP(40);
        f32x2 zc[16];
#pragma unroll
        for (int t = 0; t < 16; ++t) zc[t] = dwb;
#pragma unroll
        for (int jj = 0; jj < 31; ++jj) {
            const f32x2 w = *(const f32x2*)(dw + (size_t)jj * 1024);
#pragma unroll
            for (int t = 0; t < 16; ++t) zc[t] += w * z[t + jj];
        }
        CV_STAMP(41);
        asm volatile("" : "+v"(zc[0]), "+v"(zc[1]), "+v"(zc[2]), "+v"(zc[3]), "+v"(zc[4]), "+v"(zc[5]), "+v"(zc[6]), "+v"(zc[7]),
                          "+v"(zc[8]), "+v"(zc[9]), "+v"(zc[10]), "+v"(zc[11]), "+v"(zc[12]), "+v"(zc[13]), "+v"(zc[14]), "+v"(zc[15]) :: "memory");
        unsigned cxp[18], bg[16];
#pragma unroll
        for (int q = 0; q < 18; ++q) { const int t = t0 - 1 + q; cxp[q] = (t >= 0 && t < L) ? *(const unsigned*)(Ub + (size_t)t * UE_LD + 1024) : 0u; }
#pragma unroll
        for (int t = 0; t < 16; ++t) bg[t] = *(const unsigned*)(Ub + (size_t)(t0 + t) * UE_LD);
        LAS float* red = part + 512 + (it & 1) * (32 * 528);
        LAS float* pb = part + (it & 1) * 64;
#pragma unroll
        for (int t = 0; t < 16; ++t) { red[(2 * t) * 528 + F.tid] = zc[t].x + zc[t].y; red[(2 * t + 1) * 528 + F.tid] = zc[t].x * zc[t].x + zc[t].y * zc[t].y; }
        __syncthreads();
        { const int v = F.tid >> 4, pr = F.tid & 15; float a = 0.f;
#pragma unroll
          for (int j = 0; j < 32; ++j) a += red[v * 528 + pr + 16 * j];
          a += dpp_f<0xB1>(a); a += dpp_f<0x4E>(a); a += dpp_f<0x141>(a); a += dpp_f<0x140>(a);
          if (pr == 0) pb[v] = a; }
        __syncthreads();
        CV_STAMP(42);
        bf16_t* Ab = F.AMIX() + (size_t)(srow0 + t0) * D + ch;
#pragma unroll
        for (int t = 0; t < 16; ++t) {
            const f32x2 st = *(const LAS f32x2*)(pb + 2 * t);
            const float mu = st.x * (1.0f / 1024.0f); float var = st.y * (1.0f / 1024.0f) - mu * mu; var = var < 0.f ? 0.f : var;
            const float rs = rsqrtf(var + 1e-5f);
            const float y0 = (zc[t].x - mu) * rs * lng.x + lnb.x, y1 = (zc[t].y - mu) * rs * lng.y + lnb.y;
            *(unsigned*)(Ab + (size_t)t * D + 1024) = cvt_pk_bf16(siluf_(y0), siluf_(y1));
        }
        {
            f32x2 cx[18];
#pragma unroll
            for (int q = 0; q < 18; ++q) { cx[q].x = bf_lo(cxp[q]); cx[q].y = bf_hi(cxp[q]); }
#pragma unroll
            for (int t = 0; t < 16; ++t) {
                const f32x2 s = ca0 * cx[t] + ca1 * cx[t + 1] + ca2 * cx[t + 2];
                *(unsigned*)(Ab + (size_t)t * D) = cvt_pk_bf16(bf_lo(bg[t]) * s.x, bf_hi(bg[t]) * s.y);
            }
        }
        CV_STAMP(43);
    }
    if (NORM2_SUB >= 40 && NORM2_SUB < 50 && xb_thread0(F.wave)) atomicMax(F.ctl() + 12288 + 256 + je * 2, (unsigned)cv_acc);
    __syncthreads();
}

template <int W>
__device__ __forceinline__ void mix_tile(const bf16_t* Ub, bf16_t* Mb, int t0, int L) {
    constexpr int NR = 32 + W;
    unsigned v[NR];
#pragma unroll
    for (int i = 0; i < NR; ++i) { const int t = t0 - W / 2 + i; v[i] = (t >= 0 && t < L) ? *(const unsigned*)(Ub + (size_t)t * ODD_IN) : 0u; }
#pragma unroll
    for (int tt = 0; tt < 32; ++tt) {
        float s0 = 0.f, s1 = 0.f;
#pragma unroll
        for (int q = 0; q < W; ++q) { s0 += bf_lo(v[tt + q]); s1 += bf_hi(v[tt + q]); }
        const int t = t0 + tt; int lo = t - W / 2; int hi = lo + W - 1; lo = lo < 0 ? 0 : lo; hi = hi > L - 1 ? L - 1 : hi;
        const float inv = 1.0f / (float)(hi - lo + 1);
        const unsigned pc = v[tt + W / 2];
        *(unsigned*)(Mb + (size_t)tt * 1024) = cvt_pk_bf16(s0 * inv - bf_lo(pc), s1 * inv - bf_hi(pc));
    }
}

constexpr int AT_KLD = 136, AT_VLD = 72;
constexpr int AT_KBYTES = 64 * AT_KLD * 2, AT_VBYTES = 128 * AT_VLD * 2, AT_BUF = AT_KBYTES + AT_VBYTES;
__device__ __forceinline__ void attn_unit(const Frame& F, int jo, int b, int p, int h, bool ctxq, int half, unsigned long long& sub_acc) {
    unsigned long long sprev = (NORM2_SUB >= 20) ? __builtin_amdgcn_s_memrealtime() : 0ull;
#define AT_STAMP(k) do { if (NORM2_SUB >= 20) { const unsigned long long t_ = __builtin_amdgcn_s_memrealtime(); if (NORM2_SUB == (k)) sub_acc += t_ - sprev; sprev = t_; } } while (0)
    const int w = F.wave, lane = F.lane, ql = lane & 15, g = lane >> 4, tid = F.tid;
    const bf16_t* U = F.U(); const bf16_t* VT = F.VT();
    const int kcrow0 = NLAT + b * CTXL;
    int rs_lo = 0, nwin = 0, r_w = 0, my_lo = 0, qrow, qc = 0;
    if (!ctxq) {
        const int r0 = 2 * p, r1 = 2 * p + 1;
        int a0 = r0 - 4; a0 = a0 < 0 ? 0 : (a0 > 24 ? 24 : a0); int a1 = r1 - 4; a1 = a1 < 0 ? 0 : (a1 > 24 ? 24 : a1);
        rs_lo = a0; nwin = a1 + 8 - a0;
        r_w = r0 + (w >> 2); my_lo = (w >> 2) ? a1 : a0;
        qc = 16 * (w & 3) + ql; qrow = b * SEQ + r_w * 64 + qc;
    } else qrow = kcrow0 + half * 128 + 16 * w + ql;
    const int ntile = nwin + 4;
    bf16x8 qf[4];
#pragma unroll
    for (int kk = 0; kk < 4; ++kk) qf[kk] = *(const bf16x8*)(U + (size_t)qrow * ODD_IN + h * 128 + 32 * kk + 8 * g);
    const int kr0 = tid >> 4, kc0 = (tid & 15) * 8, vr0 = tid >> 3, vc0 = (tid & 7) * 8;
    const bf16_t* kg = U + 1024 + h * 128 + kc0;
    const bf16_t* vg = VT + (size_t)(h * 128 + vr0) * NTOK + vc0;
    LAS unsigned char* lbase = F.lds;
    u32x4 kx[2], vx[2];
#define AT_KEYROW(t) ((t) < nwin ? b * SEQ + (rs_lo + (t)) * 64 : kcrow0 + ((t) - nwin) * 64)
#define AT_LOAD(t) do { const int kr_ = AT_KEYROW(t); _Pragma("unroll") for (int p_ = 0; p_ < 2; ++p_) { \
        kx[p_] = *(const u32x4*)(kg + (size_t)(kr_ + kr0 + 32 * p_) * ODD_IN); vx[p_] = *(const u32x4*)(vg + (size_t)(64 * p_) * NTOK + kr_); } } while (0)
#define AT_STORE(buf) do { LAS unsigned char* b_ = lbase + (buf) * AT_BUF; _Pragma("unroll") for (int p_ = 0; p_ < 2; ++p_) { \
        *(LAS u32x4*)(b_ + ((kr0 + 32 * p_) * AT_KLD + kc0) * 2) = kx[p_]; { LAS unsigned char* vrow_ = b_ + AT_KBYTES + (vr0 + 64 * p_) * AT_VLD * 2; const int c_ = vc0 >> 3, ks_ = c_ >> 2, hf_ = (c_ & 3) >> 1, g0_ = 2 * (c_ & 1); \
          u32x2 lo_, hi_; lo_.x = vx[p_].x; lo_.y = vx[p_].y; hi_.x = vx[p_].z; hi_.y = vx[p_].w; \
          *(LAS u32x2*)(vrow_ + (32 * ks_ + 8 * g0_ + 4 * hf_) * 2) = lo_; *(LAS u32x2*)(vrow_ + (32 * ks_ + 8 * (g0_ + 1) + 4 * hf_) * 2) = hi_; } } } while (0)
    LAS float* rpl = (LAS float*)(lbase + 2 * AT_BUF);
    if (!ctxq && tid < 465) rpl[tid] = F.in(16)[(size_t)(jo * 8 + h) * 465 + tid] * 1.4426950408889634f;
    AT_LOAD(0); AT_STORE(0);
    __syncthreads();
    f32x4 o[8];
#pragma unroll
    for (int dt = 0; dt < 8; ++dt) o[dt] = (f32x4){0.f, 0.f, 0.f, 0.f};
    float m = -1.0e30f, lsum = 0.f;
    const float sl2 = 0.08838834764831845f * 1.4426950408889634f;
    int cs = qc - 8; cs = cs < 0 ? 0 : (cs > 48 ? 48 : cs);
#pragma unroll 1
    for (int t = 0; t < ntile; ++t) {
        const bool more = (t + 1 < ntile);
        if (more) AT_LOAD(t + 1);
        const bool win = t < nwin;
        const int jrow = rs_lo + t;
        const bool mine = !win || (jrow >= my_lo && jrow < my_lo + 8);
        AT_STAMP(99);
        if (mine) {
            const LAS unsigned char* kb = lbase + (t & 1) * AT_BUF;
            const LAS unsigned char* vb = kb + AT_KBYTES;
            f32x4 s[4];
            float mx = -1.0e30f;
            if (win) {
                const int nt0 = ((w & 3) >= 2) ? 1 : 0;
                f32x4 sb[3];
#pragma unroll
                for (int q = 0; q < 3; ++q) { sb[q] = (f32x4){0.f, 0.f, 0.f, 0.f};
#pragma unroll
                    for (int kk = 0; kk < 4; ++kk) { const bf16x8 kf = *(const LAS bf16x8*)(kb + ((16 * (nt0 + q) + ql) * AT_KLD + 32 * kk + 8 * g) * 2); sb[q] = __builtin_amdgcn_mfma_f32_16x16x32_bf16(kf, qf[kk], sb[q], 0, 0, 0); } }
                const LAS float* rpb = rpl + (jrow - r_w + 7) * 31 + 15;
#pragma unroll
                for (int q = 0; q < 3; ++q)
#pragma unroll
                    for (int i = 0; i < 4; ++i) {
                        const int kcol = 16 * (nt0 + q) + 4 * g + i;
                        int dc = kcol - qc; dc = dc < -15 ? -15 : (dc > 15 ? 15 : dc);
                        const float tv = sb[q][i] * sl2 + rpb[dc];
                        const float sv = ((unsigned)(kcol - cs) < 16u) ? tv : -1.0e30f;
                        sb[q][i] = sv; mx = fmaxf(mx, sv);
                    }
                const f32x4 neg = (f32x4){-1.0e30f, -1.0e30f, -1.0e30f, -1.0e30f};
                if (nt0) { s[0] = neg; s[1] = sb[0]; s[2] = sb[1]; s[3] = sb[2]; } else { s[0] = sb[0]; s[1] = sb[1]; s[2] = sb[2]; s[3] = neg; }
            } else {
#pragma unroll
                for (int nt = 0; nt < 4; ++nt) { s[nt] = (f32x4){0.f, 0.f, 0.f, 0.f};
#pragma unroll
                    for (int kk = 0; kk < 4; ++kk) { const bf16x8 kf = *(const LAS bf16x8*)(kb + ((16 * nt + ql) * AT_KLD + 32 * kk + 8 * g) * 2); s[nt] = __builtin_amdgcn_mfma_f32_16x16x32_bf16(kf, qf[kk], s[nt], 0, 0, 0); } }
#pragma unroll
                for (int nt = 0; nt < 4; ++nt)
#pragma unroll
                    for (int i = 0; i < 4; ++i) { const float sv = s[nt][i] * sl2; s[nt][i] = sv; mx = fmaxf(mx, sv); }
            }
            mx = fmaxf(mx, shfl_x(mx, 16, lane)); mx = fmaxf(mx, shfl_x(mx, 32, lane));
            AT_STAMP(21);
            const float mn = fmaxf(m, mx), alpha = __builtin_amdgcn_exp2f(m - mn);
            m = mn;
            float ps = 0.f;
#pragma unroll
            for (int nt = 0; nt < 4; ++nt)
#pragma unroll
                for (int i = 0; i < 4; ++i) { const float pv = __builtin_amdgcn_exp2f(s[nt][i] - mn); s[nt][i] = pv; ps += pv; }
            lsum = lsum * alpha + ps;
#pragma unroll
            for (int dt = 0; dt < 8; ++dt) o[dt] *= alpha;
            AT_STAMP(22);
#pragma unroll
            for (int ks = 0; ks < 2; ++ks) {
                u32x4 pk; pk.x = cvt_pk_bf16(s[2 * ks][0], s[2 * ks][1]); pk.y = cvt_pk_bf16(s[2 * ks][2], s[2 * ks][3]); pk.z = cvt_pk_bf16(s[2 * ks + 1][0], s[2 * ks + 1][1]); pk.w = cvt_pk_bf16(s[2 * ks + 1][2], s[2 * ks + 1][3]);
                const bf16x8 pf = __builtin_bit_cast(bf16x8, pk);
#pragma unroll
                for (int dt = 0; dt < 8; ++dt) {
                    const bf16x8 vv = *(const LAS bf16x8*)(vb + ((16 * dt + ql) * AT_VLD + 32 * ks + 8 * g) * 2);
                    o[dt] = __builtin_amdgcn_mfma_f32_16x16x32_bf16(vv, pf, o[dt], 0, 0, 0);
                }
            }
        }
        AT_STAMP(23);
        if (more) AT_STORE((t + 1) & 1);
        __syncthreads();
        AT_STAMP(20);
    }
#undef AT_KEYROW
#undef AT_LOAD
#undef AT_STORE
    lsum += shfl_x(lsum, 16, lane); lsum += shfl_x(lsum, 32, lane);
    const float inv = 1.0f / lsum;
    bf16_t* op = F.AMIX() + (size_t)qrow * D + h * 128 + 4 * g;
#pragma unroll
    for (int dt = 0; dt < 8; ++dt) st_bf16x4(op + 16 * dt, o[dt] * inv);
}

__device__ __forceinline__ void attn_mix_phase(const Frame& F, int l) {
    const int jo = l >> 1;
    const bool last = (l == DEPTH - 1);
    const int nA = NB * 16 * 8, nC = last ? 0 : NB * 2 * 8, nMix = (last ? NLAT : NTOK) / 32;
    unsigned long long sub_acc = 0ull;
#pragma unroll 1
    for (int u = F.bid; u < nA + nC + nMix; u += F.G) {
        if (u < nA + nC) {
            if (u < nA) attn_unit(F, jo, u >> 7, (u >> 3) & 15, u & 7, false, 0, sub_acc);
            else { const int v = u - nA; attn_unit(F, jo, v >> 4, 0, v & 7, true, (v >> 3) & 1, sub_acc); }
        } else {
            const int row0 = (u - nA - nC) * 32;
            int srow0, L;
            if (row0 < NLAT) { srow0 = (row0 / SEQ) * SEQ; L = SEQ; } else { srow0 = NLAT + ((row0 - NLAT) / CTXL) * CTXL; L = CTXL; }
            const int ch = 2 * F.tid, g = F.wave >> 1;
            const bf16_t* Ub = F.U() + (size_t)srow0 * ODD_IN + 3072 + ch;
            bf16_t* Mb = F.MIX() + (size_t)row0 * 1024 + ch;
            const int t0 = row0 - srow0;
            if (g == 0) mix_tile<2>(Ub, Mb, t0, L); else if (g == 1) mix_tile<4>(Ub, Mb, t0, L); else if (g == 2) mix_tile<8>(Ub, Mb, t0, L); else mix_tile<16>(Ub, Mb, t0, L);
        }
    }
    if (NORM2_SUB >= 20 && NORM2_SUB < 30 && xb_thread0(F.wave)) atomicMax(F.ctl() + 12288 + 256 + l, (unsigned)sub_acc);
}

namespace pg8 {
constexpr int BM = 256, BK = 64, HALF = 128, HTB = HALF * BK * 2, STAGE_BYTES = 8 * HTB, NXCD = 8, WGM = 8;
__device__ __forceinline__ int lds_byte(int r, int c) { const int st = (r >> 4) * 2 + (c >> 5), rr = r & 15, cc = c & 31, ob = rr * 64 + cc * 2; return st * 1024 + (ob ^ (((ob >> 9) & 1) << 5)); }
__device__ __forceinline__ void stage_rc(int b, int& R, int& C) { const int st = b / 1024, sb = b % 1024, swz = sb ^ (((sb >> 9) & 1) << 5); R = (st >> 1) * 16 + swz / 64; C = (st & 1) * 32 + (swz % 64) / 2; }
struct Unit { int pm, pn, aux; };

struct DenseSched {
    const char* A; const char* Bt; int lda, ldb, a_pn_off; int nM, nN, nwg, G, c;
    __device__ __forceinline__ void init(const void* A_, int lda_, int a_pn_off_, const void* Bt_, int ldb_, int M, int N, int G_, int c_) {
        A = (const char*)A_; Bt = (const char*)Bt_; lda = lda_; ldb = ldb_; a_pn_off = a_pn_off_; nM = M / BM; nN = N / BM; nwg = nM * nN; G = G_; c = c_; }
    __device__ __forceinline__ bool next(int i, Unit& u) const {
        const long L = (long)i * G + c; if (L >= nwg) return false;
        int wgid = (int)L; { const int q = nwg / NXCD, r = nwg % NXCD, xcd = wgid % NXCD, off = wgid / NXCD; wgid = (xcd < r ? xcd * (q + 1) : r * (q + 1) + (xcd - r) * q) + off; }
        const int nig = WGM * nN, gid = wgid / nig, fm = gid * WGM, gsz = (nM - fm) < WGM ? (nM - fm) : WGM;
        u.pm = fm + ((wgid % nig) % gsz); u.pn = (wgid % nig) / gsz; u.aux = 0; return true;
    }
    __device__ __forceinline__ const char* a_ptr(const Unit& u) const { return A + ((size_t)u.pm * BM * lda + (size_t)u.pn * a_pn_off) * 2; }
    __device__ __forceinline__ const char* b_ptr(const Unit& u) const { return Bt + (size_t)u.pn * BM * ldb * 2; }
    __device__ __forceinline__ void a_gather(const Unit&, int, unsigned (&)[2][2]) const {}
};

template <class Epi, class Sched, bool GATHER, int TAG = -100>
__device__ __forceinline__ void gemm_phase(LAS unsigned char* lds, const int tid, const int K, const int lda, const int ldb, const Sched& S, const Epi& E, unsigned* tword = nullptr) {
    unsigned long long epi_t = 0ull; const unsigned long long g_t0 = (NORM2_SUB == TAG + 1) ? __builtin_amdgcn_s_memrealtime() : 0ull;
    const int wid = __builtin_amdgcn_readfirstlane(tid >> 6), lane = tid & 63, wr = wid >> 2, wc = wid & 3, fr = lane & 15, fq = lane >> 4;
    const int nt = K / BK;
    unsigned voffA[2], voffB[2];
#pragma unroll
    for (int i = 0; i < 2; ++i) { int R, C; stage_rc(tid * 16 + i * 8192, R, C);
        voffA[i] = (unsigned)(R * lda + C) * 2u; voffB[i] = (unsigned)(R * ldb + C) * 2u; }
    const size_t kstep = (size_t)(BK * 2);
    const size_t hstepA = (size_t)HALF * lda * 2, hstepB = (size_t)HALF * ldb * 2;
    const unsigned ldsw = (unsigned)wid * 1024u;
    const int aoff = lds_byte(wr * 64 + fr, fq * 8), boff = lds_byte(wc * 32 + fr, fq * 8);
#define PG8_SA(b, h) (((b) * 2 + (h)) * HTB)
#define PG8_SB(b, h) ((4 + (b) * 2 + (h)) * HTB)
#define PG8_STAGE(bufoff, gbase, voff) do { _Pragma("unroll") for (int _i = 0; _i < 2; ++_i) \
        __builtin_amdgcn_global_load_lds((const unsigned*)((const char*)(gbase) + (voff)[_i]), (LAS unsigned*)(lds + (bufoff) + ldsw + _i * 8192), 16, 0, 0); } while (0)
#define PG8_STAGE_A(b, h, kptr, G) do { if constexpr (GATHER) PG8_STAGE(PG8_SA(b, h), kptr, (G)[h]); else PG8_STAGE(PG8_SA(b, h), (kptr) + (h) * hstepA, voffA); } while (0)
#define PG8_LDA(dst, b, h) do { _Pragma("unroll") for (int m = 0; m < 4; ++m) _Pragma("unroll") for (int k = 0; k < 2; ++k) dst[m][k] = *(const LAS bf16x8*)(lds + PG8_SA(b, h) + aoff + m * 2048 + k * 1024); } while (0)
#define PG8_LDB(dst, b, h) do { _Pragma("unroll") for (int n = 0; n < 2; ++n) _Pragma("unroll") for (int k = 0; k < 2; ++k) dst[n][k] = *(const LAS bf16x8*)(lds + PG8_SB(b, h) + boff + n * 2048 + k * 1024); } while (0)
#define PG8_MMA(ai, bj, At, Bt) do { __builtin_amdgcn_s_setprio(1); _Pragma("unroll") for (int m = 0; m < 4; ++m) _Pragma("unroll") for (int n = 0; n < 2; ++n) _Pragma("unroll") for (int k = 0; k < 2; ++k) \
        acc[ai][bj][m][n] = __builtin_amdgcn_mfma_f32_16x16x32_bf16(Bt[n][k], At[m][k], acc[ai][bj][m][n], 0, 0, 0); __builtin_amdgcn_s_setprio(0); } while (0)
#define PG8_WAIT_V(n) asm volatile("s_waitcnt vmcnt(" #n ")" ::: "memory")
#define PG8_WAIT_L(n) asm volatile("s_waitcnt lgkmcnt(" #n ")" ::: "memory")
#define PG8_BAR __builtin_amdgcn_s_barrier()
#define PG8_SCHED __builtin_amdgcn_sched_barrier(0)
    Unit cur, nxt; int ui = 0;
    if (!S.next(0, cur)) return;
    f32x4 acc[2][2][4][2];
#pragma unroll
    for (int a = 0; a < 2; ++a)
#pragma unroll
        for (int b = 0; b < 2; ++b)
#pragma unroll
            for (int m = 0; m < 4; ++m)
#pragma unroll
                for (int n = 0; n < 2; ++n) acc[a][b][m][n] = (f32x4){0.f, 0.f, 0.f, 0.f};
    bf16x8 At[4][2], B0[2][2], B1[2][2];
    const char* cA = S.a_ptr(cur); const char* cB = S.b_ptr(cur);
    unsigned gcur[2][2] = {{0u, 0u}, {0u, 0u}}, gnx[2][2] = {{0u, 0u}, {0u, 0u}};
    if constexpr (GATHER) S.a_gather(cur, tid, gcur);
    PG8_STAGE(PG8_SB(0, 0), cB, voffB); PG8_STAGE_A(0, 0, cA, gcur); PG8_STAGE(PG8_SB(0, 1), cB + hstepB, voffB); PG8_STAGE_A(0, 1, cA, gcur);
    if (wr == 1) PG8_BAR;
    PG8_WAIT_V(4); PG8_BAR;
    PG8_STAGE(PG8_SB(1, 0), cB + kstep, voffB); PG8_STAGE_A(1, 0, cA + kstep, gcur); PG8_STAGE(PG8_SB(1, 1), cB + hstepB + kstep, voffB);
    PG8_WAIT_V(6); PG8_BAR;
    for (;;) {
        const bool has_next = S.next(ui + 1, nxt);
        const char* nA = has_next ? S.a_ptr(nxt) : cA; const char* nB = has_next ? S.b_ptr(nxt) : cB;

#pragma unroll 1
        for (int t = 0; t < nt; t += 2) {
            const bool last = (t == nt - 2);
            const char* a1 = cA + (size_t)(t + 1) * kstep;
            const char* a2 = last ? nA : cA + (size_t)(t + 2) * kstep; const char* b2 = last ? nB : cB + (size_t)(t + 2) * kstep;
            const char* a3 = a2 + kstep; const char* b3 = b2 + kstep;
            unsigned g2[2][2];
#pragma unroll
            for (int h = 0; h < 2; ++h)
#pragma unroll
                for (int i = 0; i < 2; ++i) g2[h][i] = gcur[h][i];
            if constexpr (GATHER) { if (last && has_next) { S.a_gather(nxt, tid, gnx);
#pragma unroll
                for (int h = 0; h < 2; ++h)
#pragma unroll
                    for (int i = 0; i < 2; ++i) g2[h][i] = gnx[h][i]; } }
            PG8_LDB(B0, 0, 0); PG8_SCHED; PG8_LDA(At, 0, 0); PG8_STAGE_A(1, 1, a1, gcur);
            PG8_WAIT_L(8); PG8_BAR; PG8_WAIT_L(0); PG8_MMA(0, 0, At, B0); PG8_BAR; PG8_SCHED;
            PG8_LDB(B1, 0, 1); PG8_STAGE(PG8_SB(0, 0), b2, voffB);
            PG8_BAR; PG8_WAIT_L(0); PG8_MMA(0, 1, At, B1); PG8_BAR;
            PG8_LDA(At, 0, 1); PG8_STAGE_A(0, 0, a2, g2);
            PG8_BAR; PG8_WAIT_L(0); PG8_MMA(1, 0, At, B0); PG8_BAR; PG8_SCHED;
            PG8_STAGE(PG8_SB(0, 1), b2 + hstepB, voffB);
            PG8_WAIT_V(6); PG8_BAR; PG8_MMA(1, 1, At, B1); PG8_BAR;
            PG8_LDB(B0, 1, 0); PG8_SCHED; PG8_LDA(At, 1, 0); PG8_STAGE_A(0, 1, a2, g2);
            PG8_WAIT_L(8); PG8_BAR; PG8_WAIT_L(0); PG8_MMA(0, 0, At, B0); PG8_BAR; PG8_SCHED;
            PG8_LDB(B1, 1, 1); PG8_STAGE(PG8_SB(1, 0), b3, voffB);
            PG8_BAR; PG8_WAIT_L(0); PG8_MMA(0, 1, At, B1); PG8_BAR;
            PG8_LDA(At, 1, 1); PG8_STAGE_A(1, 0, a3, g2);
            PG8_BAR; PG8_WAIT_L(0); PG8_MMA(1, 0, At, B0); PG8_BAR; PG8_SCHED;
            PG8_STAGE(PG8_SB(1, 1), b3 + hstepB, voffB);
            PG8_WAIT_V(6); PG8_BAR; PG8_MMA(1, 1, At, B1); PG8_BAR;
        }
        if (NORM2_SUB == TAG) { const unsigned long long e0 = __builtin_amdgcn_s_memrealtime(); E(acc, cur, wr, wc, fr, fq); asm volatile("s_waitcnt vmcnt(0)" ::: "memory"); epi_t += __builtin_amdgcn_s_memrealtime() - e0; }
        else E(acc, cur, wr, wc, fr, fq);
        if (!has_next) break;
#pragma unroll
        for (int a = 0; a < 2; ++a)
#pragma unroll
            for (int b = 0; b < 2; ++b)
#pragma unroll
                for (int m = 0; m < 4; ++m)
#pragma unroll
                    for (int n = 0; n < 2; ++n) acc[a][b][m][n] = (f32x4){0.f, 0.f, 0.f, 0.f};
        cur = nxt; cA = nA; cB = nB; ++ui;
        if constexpr (GATHER) {
#pragma unroll
            for (int h = 0; h < 2; ++h)
#pragma unroll
                for (int i = 0; i < 2; ++i) gcur[h][i] = gnx[h][i]; }
    }
    PG8_WAIT_V(0);
    if (wr == 0) PG8_BAR;
    PG8_BAR;
    if ((NORM2_SUB == TAG || NORM2_SUB == TAG + 1) && tword && tid == 0) atomicMax(tword, (unsigned)(NORM2_SUB == TAG ? epi_t : __builtin_amdgcn_s_memrealtime() - g_t0));
#undef PG8_SA
#undef PG8_SB
#undef PG8_STAGE
#undef PG8_STAGE_A
#undef PG8_LDA
#undef PG8_LDB
#undef PG8_MMA
#undef PG8_WAIT_V
#undef PG8_WAIT_L
#undef PG8_BAR
#undef PG8_SCHED
}
}

struct FEpiU {
    bf16_t* U; int ldu; bf16_t* VT; int odd;
    __device__ __forceinline__ void operator()(const f32x4 (&acc)[2][2][4][2], const pg8::Unit& u, int wr, int wc, int fr, int fq) const {
        const int row0 = u.pm * 256 + wr * 64 + fr, col0 = u.pn * 256 + wc * 32 + 4 * fq;
        const bool vt = odd && col0 >= 2048 && col0 < 3072;
#pragma unroll
        for (int ai = 0; ai < 2; ++ai)
#pragma unroll
            for (int m = 0; m < 4; ++m) {
                const int row = row0 + ai * 128 + m * 16;
                bf16_t* rowp = U + (size_t)row * ldu + col0;
#pragma unroll
                for (int bj = 0; bj < 2; ++bj)
#pragma unroll
                    for (int n = 0; n < 2; ++n) {
                        const f32x4 v = acc[ai][bj][m][n];
                        if (!vt) st_bf16x4(rowp + bj * 128 + n * 16, v);
                        if (vt) {
                            f32x4 pv;
#pragma unroll
                            for (int i = 0; i < 4; ++i) pv[i] = dpp_f<0xB1>(v[i]);
                            const bool od = fr & 1;
                            const int cb = col0 - 2048 + bj * 128 + n * 16 + (od ? 2 : 0), rb = row - (od ? 1 : 0);
                            *(unsigned*)(VT + (size_t)cb * NTOK + rb) = cvt_pk_bf16(od ? pv[2] : v[0], od ? v[2] : pv[0]);
                            *(unsigned*)(VT + (size_t)(cb + 1) * NTOK + rb) = cvt_pk_bf16(od ? pv[3] : v[1], od ? v[3] : pv[1]);
                        }
                    }
            }
    }
};
struct FEpiUE {
    bf16_t* U;
    __device__ __forceinline__ void operator()(const f32x4 (&acc)[2][2][4][2], const pg8::Unit& u, int wr, int wc, int fr, int fq) const {
        const int row0 = u.pm * 256 + wr * 64 + fr, c0 = wc * 32 + 4 * fq;
        if (u.pn < 4) {
#pragma unroll
            for (int ai = 0; ai < 2; ++ai)
#pragma unroll
                for (int m = 0; m < 4; ++m) { bf16_t* rowp = U + (size_t)(row0 + ai * 128 + m * 16) * UE_LD + u.pn * 256 + c0;
#pragma unroll
                    for (int bj = 0; bj < 2; ++bj)
#pragma unroll
                        for (int n = 0; n < 2; ++n) st_bf16x4(rowp + bj * 128 + n * 16, acc[ai][bj][m][n]); }
        } else {
            const bool glu = u.pn >= 12;
            const int colb = (glu ? 2048 + (u.pn - 12) * 128 : 1024 + (u.pn - 4) * 128) + c0;
#pragma unroll
            for (int ai = 0; ai < 2; ++ai)
#pragma unroll
                for (int m = 0; m < 4; ++m) { bf16_t* rowp = U + (size_t)(row0 + ai * 128 + m * 16) * UE_LD + colb;
#pragma unroll
                    for (int n = 0; n < 2; ++n) { const f32x4 a = acc[ai][0][m][n], b = acc[ai][1][m][n]; f32x4 v;
#pragma unroll
                        for (int i = 0; i < 4; ++i) v[i] = glu ? a[i] * sigmoidf_(b[i]) : a[i] * b[i];
                        st_bf16x4(rowp + n * 16, v); } }
        }
    }
};
struct FEpiPool {
    bf16_t* AMIX; const float* scale;
    __device__ __forceinline__ void operator()(const f32x4 (&acc)[2][2][4][2], const pg8::Unit& u, int wr, int wc, int fr, int fq) const {
        const int row0 = u.pm * 256 + wr * 64 + fr, col0 = u.pn * 256 + wc * 32 + 4 * fq;
        f32x4 sc[2][2];
#pragma unroll
        for (int bj = 0; bj < 2; ++bj)
#pragma unroll
            for (int n = 0; n < 2; ++n) sc[bj][n] = *(const f32x4*)(scale + col0 + bj * 128 + n * 16);
#pragma unroll
        for (int bj = 0; bj < 2; ++bj)
#pragma unroll
            for (int n = 0; n < 2; ++n)
#pragma unroll
                for (int ai = 0; ai < 2; ++ai)
#pragma unroll
                    for (int m = 0; m < 4; ++m) st_bf16x4(AMIX + (size_t)(row0 + ai * 128 + m * 16) * D + 1024 + col0 + bj * 128 + n * 16, acc[ai][bj][m][n] * sc[bj][n]);
    }
};
struct FEpiRes {
    float* X; const float* MODl;
    __device__ __forceinline__ void operator()(const f32x4 (&acc)[2][2][4][2], const pg8::Unit& u, int wr, int wc, int fr, int fq) const {
        const int row0 = u.pm * 256 + wr * 64 + fr, col0 = u.pn * 256 + wc * 32 + 4 * fq;
        const int s = u.pm < 32 ? (u.pm >> 3) : 4;
        const float* g = MODl + (size_t)s * MODW + col0;
        f32x4 gv[2][2];
#pragma unroll
        for (int bj = 0; bj < 2; ++bj)
#pragma unroll
            for (int n = 0; n < 2; ++n) gv[bj][n] = *(const f32x4*)(g + bj * 128 + n * 16);
#pragma unroll
        for (int ai = 0; ai < 2; ++ai)
#pragma unroll
            for (int mp = 0; mp < 2; ++mp) {
                float* p0 = X + (size_t)(row0 + ai * 128 + (2 * mp) * 16) * D + col0;
                float* p1 = p0 + (size_t)16 * D;
                f32x4 x0, x1, x2, x3, x4, x5, x6, x7;
                asm volatile("global_load_dwordx4 %0, %8, off\n\tglobal_load_dwordx4 %1, %8, off offset:64\n\tglobal_load_dwordx4 %2, %8, off offset:512\n\tglobal_load_dwordx4 %3, %8, off offset:576\n\t"
                             "global_load_dwordx4 %4, %9, off\n\tglobal_load_dwordx4 %5, %9, off offset:64\n\tglobal_load_dwordx4 %6, %9, off offset:512\n\tglobal_load_dwordx4 %7, %9, off offset:576\n\t"
                             "s_waitcnt vmcnt(0)"
                             : "=&v"(x0), "=&v"(x1), "=&v"(x2), "=&v"(x3), "=&v"(x4), "=&v"(x5), "=&v"(x6), "=&v"(x7) : "v"(p0), "v"(p1) : "memory");
                *(f32x4*)(p0)       = x0 + gv[0][0] * acc[ai][0][2 * mp][0];
                *(f32x4*)(p0 + 16)  = x1 + gv[0][1] * acc[ai][0][2 * mp][1];
                *(f32x4*)(p0 + 128) = x2 + gv[1][0] * acc[ai][1][2 * mp][0];
                *(f32x4*)(p0 + 144) = x3 + gv[1][1] * acc[ai][1][2 * mp][1];
                *(f32x4*)(p1)       = x4 + gv[0][0] * acc[ai][0][2 * mp + 1][0];
                *(f32x4*)(p1 + 16)  = x5 + gv[0][1] * acc[ai][0][2 * mp + 1][1];
                *(f32x4*)(p1 + 128) = x6 + gv[1][0] * acc[ai][1][2 * mp + 1][0];
                *(f32x4*)(p1 + 144) = x7 + gv[1][1] * acc[ai][1][2 * mp + 1][1];
            }
    }
};

__device__ __forceinline__ void moe_tiles(const Frame& F, int l, LAS int* ts) {
    if (F.tid < NEXP) ts[33 + F.tid] = (int)__hip_atomic_load(F.ctl() + CW_CNT + l * 32 + F.tid, __ATOMIC_RELAXED, __HIP_MEMORY_SCOPE_AGENT);
    __syncthreads();
    if (F.tid == 0) { int acc = 0;
        for (int e = 0; e < NEXP; ++e) { ts[e] = acc; acc += (ts[33 + e] + 255) >> 8; }
        ts[32] = acc; }
    __syncthreads();
}
__device__ __forceinline__ int moe_find(const LAS int* ts, int ti) { int e = 0;
#pragma unroll
    for (int st = 16; st; st >>= 1) e = (ts[e + st] <= ti) ? e + st : e;
    return e; }

__device__ __forceinline__ void moe_up_phase(const Frame& F, int l) {
    LAS int* ts = (LAS int*)(F.lds + 1024);
    moe_tiles(F, l, ts);
    const int T = ts[32], fr = F.lane & 15, fq = F.lane >> 4;
#pragma unroll 1
    for (int u = F.bid; u < T * 8; u += F.G) {
        const int ti = u >> 3, q = (u >> 1) & 3, pn = u & 1;
        const int e = moe_find(ts, ti), j = ti - ts[e], cnt = ts[33 + e];
        const int* sl = F.SLOT() + (size_t)e * SLOT_CAP;
        const bf16_t* ap[4]; int sv[4];
#pragma unroll
        for (int m = 0; m < 4; ++m) { const int li = j * 256 + q * 64 + m * 16 + fr; sv[m] = li < cnt ? sl[li] : -1; const int tok = sv[m] < 0 ? 0 : (sv[m] >> 1); ap[m] = F.H() + (size_t)tok * D + 8 * fq; }
        const bf16_t* Bt = F.W13() + ((size_t)l * NEXP + e) * 512 * D;
        const bf16_t* bp0 = Bt + (size_t)(pn * 256 + F.wave * 16 + fr) * D + 8 * fq;
        const bf16_t* bp1 = bp0 + (size_t)128 * D;
        f32x4 a[4], b[4];
        sgemm_core(ap, bp0, bp1, D, a, b);
#pragma unroll
        for (int m = 0; m < 4; ++m) {
            const float gate = sv[m] < 0 ? 0.f : F.TOKG()[sv[m]];
            f32x4 hv;
#pragma unroll
            for (int i = 0; i < 4; ++i) hv[i] = sv[m] < 0 ? 0.f : siluf_(a[m][i]) * b[m][i] * gate;
            st_bf16x4(F.HID() + (size_t)(ti * 256 + q * 64 + m * 16 + fr) * FF + pn * 128 + F.wave * 16 + 4 * fq, hv);
        }
    }
}
__device__ __forceinline__ void moe_down_phase(const Frame& F, int l) {
    LAS int* ts = (LAS int*)(F.lds + 1024);
    moe_tiles(F, l, ts);
    const int T = ts[32], fr = F.lane & 15, fq = F.lane >> 4;
#pragma unroll 1
    for (int u = F.bid; u < T * 32; u += F.G) {
        const int ti = u >> 5, q = (u >> 3) & 3, pn = u & 7;
        const int e = moe_find(ts, ti), j = ti - ts[e], cnt = ts[33 + e];
        const int* sl = F.SLOT() + (size_t)e * SLOT_CAP;
        const bf16_t* ap[4]; int sv[4];
#pragma unroll
        for (int m = 0; m < 4; ++m) { const int li = j * 256 + q * 64 + m * 16 + fr; sv[m] = li < cnt ? sl[li] : -1; ap[m] = F.HID() + (size_t)(ti * 256 + q * 64 + m * 16 + fr) * FF + 8 * fq; }
        const bf16_t* Bt = F.W2() + ((size_t)l * NEXP + e) * D * FF;
        const bf16_t* bp0 = Bt + (size_t)(pn * 256 + F.wave * 16 + fr) * FF + 8 * fq;
        const bf16_t* bp1 = bp0 + (size_t)128 * FF;
        f32x4 a[4], b[4];
        sgemm_core(ap, bp0, bp1, FF, a, b);
#pragma unroll
        for (int m = 0; m < 4; ++m) if (sv[m] >= 0) {
            bf16_t* y = F.Y2() + (size_t)sv[m] * D + pn * 256 + F.wave * 16 + 4 * fq;
            st_bf16x4(y, a[m]); st_bf16x4(y + 128, b[m]);
        }
    }
}

constexpr int LDS_TS = 131072;
struct MoeSched {
    const LAS int* ts; int T, NPN, G, c;
    const char* Abase; const char* Bbase; size_t b_estride, b_pnstride, a_tstride; const int* SLOT; int lda;
    __device__ __forceinline__ int xcd_count(int x) const { const int nu = T * NPN, per = (nu + 7) >> 3; int n = nu - x * per; return n < 0 ? 0 : (n > per ? per : n); }
    __device__ __forceinline__ bool next(int i, pg8::Unit& u) const {
        int idx;
        if ((G & 7) == 0) { const int per = (T * NPN + 7) >> 3, x = c & 7, k = (c >> 3) + i * (G >> 3); if (k >= xcd_count(x)) return false; idx = x * per + k; }
        else { idx = i * G + c; if (idx >= T * NPN) return false; }
        const int ti = idx / NPN; u.pm = ti; u.pn = idx - ti * NPN; u.aux = moe_find(ts, ti); return true; }
    __device__ __forceinline__ int idle_rank() const {
        if ((G & 7) != 0) return c >= T * NPN ? c - T * NPN : -1;
        const int x = c & 7, slot = c >> 3, per8 = G >> 3; if (slot < xcd_count(x)) return -1;
        int r = slot - xcd_count(x);
        for (int xx = 0; xx < x; ++xx) r += per8 - (xcd_count(xx) < per8 ? xcd_count(xx) : per8);
        return r; }
    __device__ __forceinline__ const char* a_ptr(const pg8::Unit& u) const { return Abase + (size_t)u.pm * a_tstride; }
    __device__ __forceinline__ const char* b_ptr(const pg8::Unit& u) const { return Bbase + (size_t)u.aux * b_estride + (size_t)u.pn * b_pnstride; }
    __device__ __forceinline__ void a_gather(const pg8::Unit& u, int tid, unsigned (&off)[2][2]) const {
        const int e = u.aux, j = u.pm - ts[e], cnt = ts[33 + e];
        const int* sl = SLOT + (size_t)e * SLOT_CAP + j * 256;
#pragma unroll
        for (int i = 0; i < 2; ++i) { int R, C; pg8::stage_rc(tid * 16 + i * 8192, R, C);
#pragma unroll
            for (int h = 0; h < 2; ++h) { const int li = h * 128 + R; const int tok = (j * 256 + li < cnt) ? (sl[li] >> 1) : 0; off[h][i] = (unsigned)(tok * lda + C) * 2u; } }
    }
};
template <class S0> struct OneUnitSched {
    const S0& s; int i0;
    __device__ __forceinline__ bool next(int i, pg8::Unit& u) const { if (i != 0) return false; return s.next(i0, u); }
    __device__ __forceinline__ const char* a_ptr(const pg8::Unit& u) const { return s.a_ptr(u); }
    __device__ __forceinline__ const char* b_ptr(const pg8::Unit& u) const { return s.b_ptr(u); }
    __device__ __forceinline__ void a_gather(const pg8::Unit& u, int tid, unsigned (&off)[2][2]) const { s.a_gather(u, tid, off); }
};
struct FEpiUp {
    bf16_t* HID; const float* SLOTG; const LAS int* ts;
    __device__ __forceinline__ void operator()(const f32x4 (&acc)[2][2][4][2], const pg8::Unit& u, int wr, int wc, int fr, int fq) const {
        const int e = u.aux, j = u.pm - ts[e], cnt = ts[33 + e];
        const float* sg = SLOTG + (size_t)e * SLOT_CAP + j * 256;
#pragma unroll
        for (int ai = 0; ai < 2; ++ai) {
            float gates[4];
#pragma unroll
            for (int m = 0; m < 4; ++m) { const int r = ai * 128 + wr * 64 + m * 16 + fr; gates[m] = (j * 256 + r < cnt) ? sg[r] : 0.f; }
#pragma unroll
            for (int m = 0; m < 4; ++m) {
                const int r = ai * 128 + wr * 64 + m * 16 + fr;
                const float gate = gates[m];
                bf16_t* hp = HID + (size_t)(u.pm * 256 + r) * FF + u.pn * 128 + wc * 32 + 4 * fq;
#pragma unroll
                for (int n = 0; n < 2; ++n) { const f32x4 a = acc[ai][0][m][n], b = acc[ai][1][m][n]; f32x4 hv;
#pragma unroll
                    for (int i = 0; i < 4; ++i) hv[i] = siluf_(a[i]) * b[i] * gate;
                    st_bf16x4(hp + n * 16, hv); }
            }
        }
    }
};
struct FEpiDown {
    bf16_t* Y2; const int* SLOT; const LAS int* ts;
    __device__ __forceinline__ void operator()(const f32x4 (&acc)[2][2][4][2], const pg8::Unit& u, int wr, int wc, int fr, int fq) const {
        const int e = u.aux, j = u.pm - ts[e], cnt = ts[33 + e];
        const int* sl = SLOT + (size_t)e * SLOT_CAP + j * 256;
        int svs[2][4];
#pragma unroll
        for (int ai = 0; ai < 2; ++ai)
#pragma unroll
            for (int m = 0; m < 4; ++m) { const int r = ai * 128 + wr * 64 + m * 16 + fr; svs[ai][m] = (j * 256 + r < cnt) ? sl[r] : -1; }
#pragma unroll
        for (int ai = 0; ai < 2; ++ai)
#pragma unroll
            for (int m = 0; m < 4; ++m) {
                if (svs[ai][m] >= 0) {
                    bf16_t* yp = Y2 + (size_t)svs[ai][m] * D + u.pn * 256 + wc * 32 + 4 * fq;
#pragma unroll
                    for (int bj = 0; bj < 2; ++bj)
#pragma unroll
                        for (int n = 0; n < 2; ++n) st_bf16x4(yp + bj * 128 + n * 16, acc[ai][bj][m][n]);
                }
            }
    }
};
__device__ __forceinline__ void moe_up_fast(const Frame& F, int l) {
    LAS int* ts = (LAS int*)(F.lds + LDS_TS);
    moe_tiles(F, l, ts);
    MoeSched S; S.ts = ts; S.T = ts[32]; S.NPN = 2; S.G = F.G; S.c = F.bid;
    S.Abase = (const char*)F.H(); S.a_tstride = 0; S.Bbase = (const char*)(F.W13() + (size_t)l * NEXP * 512 * D); S.b_estride = (size_t)512 * D * 2; S.b_pnstride = (size_t)256 * D * 2;
    S.SLOT = F.SLOT(); S.lda = D;
    FEpiUp E{F.HID(), F.SLOTG(), ts};
#pragma unroll 1
    for (int i0 = 0; ; ++i0) { pg8::Unit u0; if (!S.next(i0, u0)) break;
        OneUnitSched<MoeSched> S1{S, i0};
        pg8::gemm_phase<FEpiUp, OneUnitSched<MoeSched>, true>(F.lds, F.tid, D, D, D, S1, E); }
    if (F.G == 256) { const CvtPlan cp = cvt_plan(l, F.G); const int nu = S.T * 2;
        if (nu < F.G) { const int ir = S.idle_rank(); if (ir >= 0) convert_layer(F, l, ir, F.G - nu, cp.u_lo, cp.nt); } else convert_layer(F, l, F.bid, F.G, cp.u_lo, cp.nt); }
}
__device__ __forceinline__ void moe_down_fast(const Frame& F, int l) {
    LAS int* ts = (LAS int*)(F.lds + LDS_TS);
    moe_tiles(F, l, ts);
    MoeSched S; S.ts = ts; S.T = ts[32]; S.NPN = 8; S.G = F.G; S.c = F.bid;
    S.Abase = (const char*)F.HID(); S.a_tstride = (size_t)256 * FF * 2; S.Bbase = (const char*)(F.W2() + (size_t)l * NEXP * D * FF); S.b_estride = (size_t)D * FF * 2; S.b_pnstride = (size_t)256 * FF * 2;
    S.SLOT = F.SLOT(); S.lda = FF;
    FEpiDown E{F.Y2(), F.SLOT(), ts};
    pg8::gemm_phase<FEpiDown, MoeSched, false>(F.lds, F.tid, FF, FF, FF, S, E);
}

__global__ void __launch_bounds__(512, 2) hybrid_fwd(Args args) {
    extern __shared__ __attribute__((aligned(16))) unsigned char lds_raw[];
    Frame F;
    F.lds = (LAS unsigned char*)lds_raw;
    F.tid = threadIdx.x; F.lane = F.tid & 63; F.wave = __builtin_amdgcn_readfirstlane(F.tid >> 6);
    F.G = gridDim.x; F.bid = blockIdx.x;
    F.ka = (const CAS Args*)__builtin_amdgcn_kernarg_segment_ptr();

    volatile LAS unsigned* misc = (volatile LAS unsigned*)(F.lds + LDS_MISC);
    if (F.tid < 64) misc[F.tid] = 0u;
    __syncthreads();
    XcdBarrier bar; bar.bar = F.ctl(); bar.x = 0; bar.st = misc; bar.wave = F.wave;
#if MK_N_LAUNCHES == 1
    bar = xcd_barrier_post(F.ctl(), misc);
#endif
    const int lo = F.ka->ph_lo, hi = F.ka->ph_hi;
    int ph = 0;
    constexpr int CW_PR = 12288;
#define PROBE_MARK(kind) do { if (PROBE_KA >= 0) { if (xb_thread0(F.wave)) { int b_ = F.bid; asm volatile("" : "+s"(b_)); const unsigned t_ = (unsigned)__builtin_amdgcn_s_memrealtime(); atomicMax(F.ctl() + CW_PR + ph, t_); atomicMax(F.ctl() + CW_PR + 64 + ph, ~t_); \
        if (b_ == 0) F.ctl()[CW_PR + 128 + ph] = (unsigned)((kind) + 1); } } } while (0)
#if MK_N_LAUNCHES == 1
#define PHASE_BEGIN(kind) ({ const bool run_ = (lo <= ph && ph < hi); PROBE_MARK(kind); if (run_ && ph > lo) xcd_barrier(bar); ++ph; run_; })
#else
#define PHASE_BEGIN(kind) ({ const bool run_ = (lo <= ph && ph < hi); ++ph; run_; })
#endif

    if (PHASE_BEGIN(0)) { if (ON(0)) for (int rep = 0; rep < REPS(0); ++rep) { const Frame P = phase_frame(F); mod_layer(P, 0, P.bid, P.G); } }
#pragma unroll 1
    for (int l = 0; l < DEPTH; ++l) {
        const bool odd = l & 1, last = (l == DEPTH - 1);
        const int jh = l >> 1;
        if (PHASE_BEGIN(1)) { if (ON(1)) { const Frame P = phase_frame(F); if (l == 0) { norm1_phase<0>(P, l); p0_convert(phase_frame(F)); } else norm1_phase<1>(P, l); } }
        if (PHASE_BEGIN(2)) {
            const Frame P = phase_frame(F);
            const int N = odd ? ODD_IN : EVEN_IN;
            const bf16_t* Bt = odd ? P.ODWIN() + (size_t)jh * ODD_IN * D : P.EVWIN() + (size_t)jh * EVEN_IN * D;
            EpiU E{P.U(), N, P.VT(), odd ? 1 : 0};
            if (ON(2)) for (int rep = 0; rep < REPS(2); ++rep) { pg8::DenseSched S; S.init(P.H(), D, 0, Bt, D, NTOK, N, P.G, P.bid);
                if (odd) { FEpiU FE{P.U(), N, P.VT(), 1}; pg8::gemm_phase<FEpiU, pg8::DenseSched, false, 30>(P.lds, P.tid, D, D, D, S, FE, P.ctl() + 12288 + 256 + l);
                    const int three = (NTOK / 256) * (ODD_IN / 256) - 2 * P.G;
                    if (rep == 0 && P.G == 256 && P.bid >= three) convert_layer(P, l, P.bid - three, P.G - three, 0, CVT_SPLIT); }
                else { FEpiUE FE{P.U()}; pg8::gemm_phase<FEpiUE, pg8::DenseSched, false, 30>(P.lds, P.tid, D, D, D, S, FE, P.ctl() + 12288 + 256 + l);
                    const int three = (NTOK / 256) * (EVEN_IN / 256) - 2 * P.G;
                    if (rep == 0 && P.G == 256 && P.bid >= three) convert_layer(P, l, P.bid - three, P.G - three, 0, CVT_E1); } }
        }
        if (!odd) { if (PHASE_BEGIN(3)) { if (ON(3)) for (int rep = 0; rep < REPS(3); ++rep) { const Frame P = phase_frame(F); conv_phase(P, jh);
                if (rep == 0 && P.G == 256 && P.bid >= 64) convert_layer(P, l, P.bid - 64, P.G - 64, CVT_E1, CVT_E2); } } }
        else {
            if (PHASE_BEGIN(4)) { if (ON(4)) for (int rep = 0; rep < REPS(4); ++rep) { const Frame P = phase_frame(F); attn_mix_phase(P, l); } }
            if (PHASE_BEGIN(5)) if (ON(5)) { const Frame P = phase_frame(F); pg8::DenseSched S; S.init(P.MIX(), 1024, 256, P.POOLW() + (size_t)jh * 1024 * 256, 256, last ? NLAT : NTOK, 1024, P.G, P.bid); FEpiPool FE{P.AMIX(), P.in(18) + (size_t)jh * 1024};
                pg8::gemm_phase<FEpiPool, pg8::DenseSched, false>(P.lds, P.tid, 256, 1024, 256, S, FE);
                const int nu = ((last ? NLAT : NTOK) / 256) * 4;
                if (P.G == 256 && P.bid >= nu) { const CvtPlan cp = cvt_plan(DEPTH - 1, P.G); const int mid = (cp.c_hi + cp.n_lo) >> 1;
                    convert_layer(phase_frame(F), DEPTH - 1, P.bid - nu, P.G - nu, last ? mid : cp.c_hi, last ? cp.n_lo : mid); } }
        }
        if (PHASE_BEGIN(6)) {
            const Frame P = phase_frame(F);
            const bf16_t* Bt = odd ? P.ODWOUT() + (size_t)jh * D * D : P.EVWOUT() + (size_t)jh * D * D;
            EpiRes E{P.X(), P.MOD() + (size_t)l * 5 * MODW + 2 * D};
            if (ON(6)) { pg8::DenseSched S; S.init(P.AMIX(), D, 0, Bt, D, last ? NLAT : NTOK, D, P.G, P.bid); FEpiRes FE{P.X(), P.MOD() + (size_t)l * 5 * MODW + 2 * D};
                pg8::gemm_phase<FEpiRes, pg8::DenseSched, false, 32>(P.lds, P.tid, D, D, D, S, FE, P.ctl() + 12288 + 256 + l);
                if (!last) { const int two = (NTOK / 256) * (D / 256) - P.G;
                    const CvtPlan cp = cvt_plan(l, P.G);
                    if (two > 0 && two < P.G) { if (P.bid >= two) { convert_layer(P, l, P.bid - two, P.G - two, cp.c_hi, cp.n_lo); mod_layer(phase_frame(F), l + 1, P.bid - two, P.G - two); } }
                    else { convert_layer(P, l, P.bid, P.G, cp.c_hi, cp.n_lo); mod_layer(phase_frame(F), l + 1, P.bid, P.G); } }
                else if (P.G != 256) { const CvtPlan cp = cvt_plan(l, P.G); convert_layer(P, l, P.bid, P.G, cp.c_hi, cp.n_lo); } }
        }
        if (PHASE_BEGIN(7)) { if (ON(7)) { if (REPS(7) > 1) { const Frame P = phase_frame(F); norm2_router_phase(P, l, true); } const Frame P = phase_frame(F); norm2_router_phase(P, l);
            if (!last && P.G == 256 && P.bid >= 64) { const CvtPlan cp = cvt_plan(l, P.G); convert_layer(P, l, P.bid - 64, P.G - 64, cp.n_lo, cp.u_lo); } } }
        if (PHASE_BEGIN(8)) { if (ON(8)) for (int rep = 0; rep < REPS(8); ++rep) { const Frame P = phase_frame(F); moe_up_fast(P, l); } }
        if (PHASE_BEGIN(9)) { if (ON(9)) for (int rep = 0; rep < REPS(9); ++rep) { const Frame P = phase_frame(F); moe_down_fast(P, l); } }
    }
    if (PHASE_BEGIN(10)) { if (ON(10)) for (int rep = 0; rep < REPS(10); ++rep) { const Frame P = phase_frame(F); norm1_phase<2>(P, DEPTH); } }
    if (PROBE_KA >= 0) { PROBE_MARK(-1); xcd_barrier(bar);
        int b2_ = F.bid; asm volatile("" : "+s"(b2_));
        if (b2_ == 0 && xb_thread0(F.wave)) { unsigned long long acc_t = 0ull;
            for (int q = 0; q < ph; ++q) { if ((int)__hip_atomic_load(F.ctl() + CW_PR + 128 + q, __ATOMIC_RELAXED, __HIP_MEMORY_SCOPE_AGENT) == PROBE_KA + 1) {
                const unsigned mx1 = __hip_atomic_load(F.ctl() + CW_PR + q + 1, __ATOMIC_RELAXED, __HIP_MEMORY_SCOPE_AGENT), mx0 = __hip_atomic_load(F.ctl() + CW_PR + q, __ATOMIC_RELAXED, __HIP_MEMORY_SCOPE_AGENT);
                const unsigned mn1 = ~__hip_atomic_load(F.ctl() + CW_PR + 64 + q + 1, __ATOMIC_RELAXED, __HIP_MEMORY_SCOPE_AGENT);
                acc_t += (PROBE_KB == 1) ? (unsigned long long)(mx1 - mn1) : (unsigned long long)(mx1 - mx0); } }
            if (PROBE_KA == 77) { acc_t = 0ull; for (int q = 0; q < DEPTH; ++q) acc_t += __hip_atomic_load(F.ctl() + 12288 + 256 + q, __ATOMIC_RELAXED, __HIP_MEMORY_SCOPE_AGENT); }
            const unsigned long long extra = (acc_t / 100ull) * 1000ull * 100ull; const unsigned long long t0 = __builtin_amdgcn_s_memrealtime();
            while (__builtin_amdgcn_s_memrealtime() - t0 < extra) __builtin_amdgcn_s_sleep(32); } }
#if TRUNC
    if (lo == 99) { const Frame P = phase_frame(F);
        for (size_t i = (size_t)P.bid * 512 + P.tid; i < (size_t)NLAT * D / 4; i += (size_t)P.G * 512) {
#if DUMP_SEL == 0
            ((f32x4*)P.out())[i] = ((const f32x4*)P.X())[i];
#elif DUMP_SEL == 1
            const u32x2 a = ((const u32x2*)P.AMIX())[i]; f32x4 v; v[0] = bf_lo(a.x); v[1] = bf_hi(a.x); v[2] = bf_lo(a.y); v[3] = bf_hi(a.y); ((f32x4*)P.out())[i] = v;
#elif DUMP_SEL == 2
            f32x4 v = {0.f, 0.f, 0.f, 0.f}; if (i < (size_t)1024 * NTOK / 4) { const u32x2 a = ((const u32x2*)P.VT())[i]; v[0] = bf_lo(a.x); v[1] = bf_hi(a.x); v[2] = bf_lo(a.y); v[3] = bf_hi(a.y); } ((f32x4*)P.out())[i] = v;
#else
            f32x4 v = {0.f, 0.f, 0.f, 0.f}; if (i < (size_t)1024 * NTOK / 4) { const u32x2 a = ((const u32x2*)P.MIX())[i]; v[0] = bf_lo(a.x); v[1] = bf_hi(a.x); v[2] = bf_lo(a.y); v[3] = bf_hi(a.y); } ((f32x4*)P.out())[i] = v;
#endif
        } }
#endif
}
constexpr int N_PHASES = 1 + (7 + 8 + 7 + 8) + 1;

extern "C" void kernel_launch(void* const* d_in, const int* in_sizes, int n_in, void* d_out, int out_size, void* d_ws, size_t ws_size, hipStream_t stream) {
    static int grid = 0;
    if (grid == 0) {
        if (n_in != 28 || in_sizes[0] != NLAT * D || out_size != NLAT * D || ws_size < WS_END) {
            fprintf(stderr, "kernel_launch: unexpected shapes (n_in %d, in0 %d, out %d, ws %zu < %zu); nothing launched\n", n_in, n_in > 0 ? in_sizes[0] : -1, out_size, ws_size, (size_t)WS_END); grid = -1; return; }
        int dev = 0, cus = 0, per_cu = 0;
        if (hipGetDevice(&dev) != hipSuccess || hipDeviceGetAttribute(&cus, hipDeviceAttributeMultiprocessorCount, dev) != hipSuccess) { grid = -1; return; }
        if (hipFuncSetAttribute((const void*)hybrid_fwd, hipFuncAttributeMaxDynamicSharedMemorySize, LDS_BYTES) != hipSuccess) { fprintf(stderr, "kernel_launch: hipFuncSetAttribute failed\n"); grid = -1; return; }
        if (hipOccupancyMaxActiveBlocksPerMultiprocessor(&per_cu, (const void*)hybrid_fwd, 512, LDS_BYTES) != hipSuccess || per_cu < 1)
            fprintf(stderr, "kernel_launch: occupancy query reports %d blocks per CU\n", per_cu);
        (void)hipGetLastError();
        grid = cus;
    }
    if (grid < 0) return;
    if (hipMemsetAsync((char*)d_ws + WS_CTL, 0, CTL_BYTES, stream) != hipSuccess) { fprintf(stderr, "kernel_launch: memset failed\n"); return; }
    Args a{};
    for (int i = 0; i < 28; ++i) a.in[i] = (const float*)d_in[i];
    a.out = (float*)d_out; a.ws = (unsigned char*)d_ws;
#if MK_N_LAUNCHES == 1
    a.ph_lo = 0; a.ph_hi = N_PHASES;
    hipLaunchKernelGGL(hybrid_fwd, dim3(grid), dim3(512), LDS_BYTES, stream, a);
#else
#if TRUNC
    for (int p = 0; p < TRUNC; ++p) { a.ph_lo = p; a.ph_hi = p + 1; hipLaunchKernelGGL(hybrid_fwd, dim3(grid), dim3(512), LDS_BYTES, stream, a); }
    a.ph_lo = 99; a.ph_hi = 100; hipLaunchKernelGGL(hybrid_fwd, dim3(grid), dim3(512), LDS_BYTES, stream, a);
#else
    for (int p = 0; p < N_PHASES; ++p) { a.ph_lo = p; a.ph_hi = p + 1; hipLaunchKernelGGL(hybrid_fwd, dim3(grid), dim3(512), LDS_BYTES, stream, a); }
#endif
#endif
    const hipError_t le = hipPeekAtLastError();
    if (le != hipSuccess) fprintf(stderr, "kernel_launch: launch failed: %s\n", hipGetErrorName(le));
}
```
